# Optimizing an MI355X kernel written in HIP

```python
import math
import jax, jax.numpy as jnp
from jax import lax
import numpy as np

D_MODEL = 1024
BATCH = 4
SEQ = 4096
DEPTH = 1

NSA_HEADS = 8
NSA_KV_GROUPS = 2
NSA_HPG = NSA_HEADS // NSA_KV_GROUPS
NSA_HEAD_DIM = 64
NSA_WIDTH = NSA_HEADS * NSA_HEAD_DIM
NSA_KV_WIDTH = NSA_KV_GROUPS * NSA_HEAD_DIM
CMP_BLOCK = 32
CMP_STRIDE = 16
SLC_BLOCK = 64
SLC_TOPN = 16
WINDOW = 512
Q_BLOCK = 128
SLC_Q_BLOCK = 64
CONV_CH = 512
CONV_WIDTH = 31
PEER_HEADS = 8
PEER_NKEYS = 128
PEER_EXPERTS = PEER_NKEYS * PEER_NKEYS
PEER_QDIM = 256
PEER_HALF = PEER_QDIM // 2
PEER_TOPK = 16
PEER_CHUNK = 128

EPS = 1e-6
NEG = -1e30
FORCED = 1e9

IN_SPLIT_SIZES = (NSA_WIDTH,
                  NSA_KV_WIDTH, NSA_KV_WIDTH,
                  NSA_KV_WIDTH, NSA_KV_WIDTH,
                  NSA_KV_WIDTH, NSA_KV_WIDTH,
                  3 * NSA_HEADS,
                  2 * CONV_CH,
                  2 * D_MODEL)
IN_COLS = sum(IN_SPLIT_SIZES)

kernel_name = "hybrid_nsa_conformer_peer_block"


def rmsnorm(x, g):
    xf = x.astype(jnp.float32)
    y = xf * lax.rsqrt(jnp.mean(xf * xf, axis=-1, keepdims=True) + EPS)
    return (y * g.astype(jnp.float32)).astype(x.dtype)


def alibi_slopes(n):
    return jnp.asarray(np.array([2.0 ** (-8.0 * (h + 1) / n) for h in range(n)], np.float32))


def masked_softmax(s, mask):
    s = jnp.where(mask, s.astype(jnp.float32), NEG)
    return jnp.where(mask, jax.nn.softmax(s, axis=-1), 0.0)


def nsa_compressed(q, k, v, pe_k, pe_v, w_k1, w_k2, w_v1, w_v2, slopes_gh):
    B, S = q.shape[0], q.shape[1]
    n_cmp = (S - CMP_BLOCK) // CMP_STRIDE + 1
    idx = np.arange(n_cmp)[:, None] * CMP_STRIDE + np.arange(CMP_BLOCK)[None, :]

    def compress(t, pe, w1, w2):
        blk = t[:, idx] + pe[None, None, :, None, :]
        blk = blk.transpose(0, 1, 3, 2, 4).reshape(B, n_cmp, NSA_KV_GROUPS, CMP_BLOCK * NSA_HEAD_DIM)
        return jax.nn.gelu(blk @ w1, approximate=False) @ w2

    kc = compress(k, pe_k, w_k1, w_k2)
    vc = compress(v, pe_v, w_v1, w_v2)
    t = np.arange(S)
    end = idx[:, -1]
    mask = end[None, :] <= t[:, None]
    dist = (t[:, None] - end[None, :]).astype(np.float32)
    s = jnp.einsum('bsghd,bngd->bghsn', q, kc).astype(jnp.float32) / math.sqrt(NSA_HEAD_DIM)
    s = s - slopes_gh[:, :, None, None] * dist
    p = masked_softmax(s, mask)
    o = jnp.einsum('bghsn,bngd->bsghd', p.astype(vc.dtype), vc)
    return o, p, idx


def nsa_selected(q, k, v, p_cmp, cmp_idx, slopes_gh):
    B, S = q.shape[0], q.shape[1]
    n_slc = S // SLC_BLOCK
    n_sel = min(SLC_TOPN, n_slc)
    starts = cmp_idx[:, 0]
    ends = cmp_idx[:, -1]
    j = np.arange(n_slc)
    overlap = ((starts[:, None] <= (j[None, :] + 1) * SLC_BLOCK - 1) &
               (ends[:, None] >= j[None, :] * SLC_BLOCK)).astype(np.float32)
    imp = jnp.einsum('bghsn,nj->bgsj', p_cmp, overlap)
    t = np.arange(S)
    t_blk = t // SLC_BLOCK
    future = j[None, :] > t_blk[:, None]
    forced = (j[None, :] == 0) | (j[None, :] == t_blk[:, None]) | (j[None, :] == t_blk[:, None] - 1)
    imp = jnp.where(forced, FORCED, jnp.where(future, NEG, imp))
    _, sel = lax.top_k(imp, n_sel)

    kblk = k.reshape(B, n_slc, SLC_BLOCK, NSA_KV_GROUPS, NSA_HEAD_DIM).transpose(0, 3, 1, 2, 4)
    vblk = v.reshape(B, n_slc, SLC_BLOCK, NSA_KV_GROUPS, NSA_HEAD_DIM).transpose(0, 3, 1, 2, 4)
    nqb = S // SLC_Q_BLOCK
    qb_all = q.transpose(0, 2, 1, 3, 4).reshape(B, NSA_KV_GROUPS, nqb, SLC_Q_BLOCK, NSA_HPG, NSA_HEAD_DIM)
    qb_all = jnp.moveaxis(qb_all, 2, 0)
    sel_all = jnp.moveaxis(sel.reshape(B, NSA_KV_GROUPS, nqb, SLC_Q_BLOCK, n_sel), 2, 0)
    q0_all = jnp.arange(nqb, dtype=jnp.int32) * SLC_Q_BLOCK
    bi = jnp.arange(B)[:, None, None, None]
    gi = jnp.arange(NSA_KV_GROUPS)[None, :, None, None]
    n_keys = n_sel * SLC_BLOCK

    def body(xs):
        qb, sb, q0 = xs
        kg = kblk[bi, gi, sb].reshape(B, NSA_KV_GROUPS, SLC_Q_BLOCK, n_keys, NSA_HEAD_DIM)
        vg = vblk[bi, gi, sb].reshape(B, NSA_KV_GROUPS, SLC_Q_BLOCK, n_keys, NSA_HEAD_DIM)
        kpos = (sb[..., None] * SLC_BLOCK + jnp.arange(SLC_BLOCK)).reshape(B, NSA_KV_GROUPS, SLC_Q_BLOCK, n_keys)
        tq = q0 + jnp.arange(SLC_Q_BLOCK)
        diff = tq[None, None, :, None] - kpos
        s = jnp.einsum('bgqhd,bgqkd->bgqhk', qb, kg).astype(jnp.float32) / math.sqrt(NSA_HEAD_DIM)
        s = s - slopes_gh[None, :, None, :, None] * diff[:, :, :, None, :].astype(jnp.float32)
        p = masked_softmax(s, (diff >= 0)[:, :, :, None, :])
        return jnp.einsum('bgqhk,bgqkd->bgqhd', p.astype(vg.dtype), vg)

    o = lax.map(body, (qb_all, sel_all, q0_all))
    return o.transpose(1, 0, 3, 2, 4, 5).reshape(B, S, NSA_KV_GROUPS, NSA_HPG, NSA_HEAD_DIM)


def nsa_window(q, k, v, slopes_gh):
    B, S = q.shape[0], q.shape[1]
    nqb = S // Q_BLOCK
    span = WINDOW + Q_BLOCK
    kp = jnp.pad(k, ((0, 0), (WINDOW, 0), (0, 0), (0, 0)))
    vp = jnp.pad(v, ((0, 0), (WINDOW, 0), (0, 0), (0, 0)))
    idx = np.arange(nqb)[:, None] * Q_BLOCK + np.arange(span)[None, :]
    kw = kp[:, idx]
    vw = vp[:, idx]
    kpos = idx - WINDOW
    tq = np.arange(nqb)[:, None] * Q_BLOCK + np.arange(Q_BLOCK)[None, :]
    diff = tq[:, :, None] - kpos[:, None, :]
    mask = (diff >= 0) & (diff < WINDOW) & (kpos >= 0)[:, None, :]
    qw = q.reshape(B, nqb, Q_BLOCK, NSA_KV_GROUPS, NSA_HPG, NSA_HEAD_DIM)
    s = jnp.einsum('bcqghd,bckgd->bcghqk', qw, kw).astype(jnp.float32) / math.sqrt(NSA_HEAD_DIM)
    s = s - slopes_gh[None, None, :, :, None, None] * diff.astype(np.float32)[None, :, None, None, :, :]
    p = masked_softmax(s, mask[None, :, None, None, :, :])
    o = jnp.einsum('bcghqk,bckgd->bcqghd', p.astype(vw.dtype), vw)
    return o.reshape(B, S, NSA_KV_GROUPS, NSA_HPG, NSA_HEAD_DIM)


def conformer_conv(glu_in, w_dw, b_dw, g_ln, b_ln):
    a, b = jnp.split(glu_in, 2, axis=-1)
    u = a * jax.nn.sigmoid(b)
    u = lax.conv_general_dilated(u, w_dw, window_strides=(1,), padding=[(CONV_WIDTH - 1, 0)],
                                 dimension_numbers=('NWC', 'WIO', 'NWC'),
                                 feature_group_count=CONV_CH) + b_dw
    uf = u.astype(jnp.float32)
    mu = jnp.mean(uf, axis=-1, keepdims=True)
    var = jnp.mean(jnp.square(uf - mu), axis=-1, keepdims=True)
    un = ((uf - mu) * lax.rsqrt(var + EPS) * g_ln.astype(jnp.float32) + b_ln.astype(jnp.float32)).astype(u.dtype)
    return jax.nn.silu(un)


def peer_ffn(xn, w_q, sub_keys, u_tab, v_tab):
    B, S, D = xn.shape
    q = (xn @ w_q).reshape(B, S, PEER_HEADS, 2, PEER_HALF)
    s1 = jnp.einsum('bshd,hkd->bshk', q[..., 0, :], sub_keys[:, 0]).astype(jnp.float32)
    s2 = jnp.einsum('bshd,hkd->bshk', q[..., 1, :], sub_keys[:, 1]).astype(jnp.float32)
    v1, i1 = lax.top_k(s1, PEER_TOPK)
    v2, i2 = lax.top_k(s2, PEER_TOPK)
    cand = (v1[..., :, None] + v2[..., None, :]).reshape(B, S, PEER_HEADS, PEER_TOPK * PEER_TOPK)
    cs, ci = lax.top_k(cand, PEER_TOPK)
    e = (jnp.take_along_axis(i1, ci // PEER_TOPK, axis=-1) * PEER_NKEYS +
         jnp.take_along_axis(i2, ci % PEER_TOPK, axis=-1))
    g = jax.nn.softmax(cs, axis=-1)
    T = B * S
    nch = T // PEER_CHUNK
    xs = (xn.reshape(nch, PEER_CHUNK, D),
          e.reshape(nch, PEER_CHUNK, PEER_HEADS, PEER_TOPK),
          g.reshape(nch, PEER_CHUNK, PEER_HEADS, PEER_TOPK))

    def body(args):
        xc, ec, gc = args
        u = u_tab[ec]
        h = jnp.einsum('cd,chkd->chk', xc, u)
        a = (jax.nn.gelu(h.astype(jnp.float32), approximate=False) * gc).astype(xc.dtype)
        return jnp.einsum('chk,chkd->cd', a, v_tab[ec])

    return lax.map(body, xs).reshape(B, S, D)


def setup_inputs(seed: int = 0) -> dict:
    key = jax.random.key(seed)
    ks = jax.random.split(key, 24)
    L = DEPTH
    f = jnp.float32

    def nrm(k, shape, scale):
        return jax.random.normal(k, shape, f) * scale

    return {
        "x": jax.random.normal(ks[0], (BATCH, SEQ, D_MODEL), f),
        "g_mix": 1.0 + nrm(ks[1], (L, D_MODEL), 0.01),
        "w_in": nrm(ks[2], (L, D_MODEL, IN_COLS), D_MODEL ** -0.5),
        "pe_cmp_k": nrm(ks[3], (L, CMP_BLOCK, NSA_HEAD_DIM), 0.02),
        "pe_cmp_v": nrm(ks[4], (L, CMP_BLOCK, NSA_HEAD_DIM), 0.02),
        "w_cmp_k1": nrm(ks[5], (L, CMP_BLOCK * NSA_HEAD_DIM, NSA_HEAD_DIM), (CMP_BLOCK * NSA_HEAD_DIM) ** -0.5),
        "w_cmp_k2": nrm(ks[6], (L, NSA_HEAD_DIM, NSA_HEAD_DIM), NSA_HEAD_DIM ** -0.5),
        "w_cmp_v1": nrm(ks[7], (L, CMP_BLOCK * NSA_HEAD_DIM, NSA_HEAD_DIM), (CMP_BLOCK * NSA_HEAD_DIM) ** -0.5),
        "w_cmp_v2": nrm(ks[8], (L, NSA_HEAD_DIM, NSA_HEAD_DIM), NSA_HEAD_DIM ** -0.5),
        "w_nsa_out": nrm(ks[9], (L, NSA_WIDTH, D_MODEL), NSA_WIDTH ** -0.5),
        "w_dw": nrm(ks[10], (L, CONV_WIDTH, 1, CONV_CH), CONV_WIDTH ** -0.5),
        "b_dw": nrm(ks[11], (L, CONV_CH), 0.01),
        "g_conv_ln": 1.0 + nrm(ks[12], (L, CONV_CH), 0.01),
        "b_conv_ln": nrm(ks[13], (L, CONV_CH), 0.01),
        "w_conv_out": nrm(ks[14], (L, CONV_CH, D_MODEL), CONV_CH ** -0.5),
        "w_o": nrm(ks[15], (L, D_MODEL, D_MODEL), D_MODEL ** -0.5),
        "g_ffn": 1.0 + nrm(ks[16], (L, D_MODEL), 0.01),
        "w_peer_q": nrm(ks[17], (L, D_MODEL, PEER_HEADS * PEER_QDIM), D_MODEL ** -0.5),
        "peer_sub_keys": nrm(ks[18], (L, PEER_HEADS, 2, PEER_NKEYS, PEER_HALF), PEER_HALF ** -0.5),
        "peer_u": nrm(ks[19], (L, PEER_EXPERTS, D_MODEL), D_MODEL ** -0.5),
        "peer_v": nrm(ks[20], (L, PEER_EXPERTS, D_MODEL), (PEER_HEADS * PEER_TOPK) ** -0.5),
        "g_final": 1.0 + nrm(ks[21], (D_MODEL,), 0.01),
    }


def reference(x, g_mix, w_in, pe_cmp_k, pe_cmp_v, w_cmp_k1, w_cmp_k2, w_cmp_v1, w_cmp_v2,
              w_nsa_out, w_dw, b_dw, g_conv_ln, b_conv_ln, w_conv_out, w_o,
              g_ffn, w_peer_q, peer_sub_keys, peer_u, peer_v, g_final):
    B, S, D = x.shape
    slopes_gh = alibi_slopes(NSA_HEADS).reshape(NSA_KV_GROUPS, NSA_HPG)
    split_pts = np.cumsum(IN_SPLIT_SIZES)[:-1].tolist()
    kv_shape = (B, S, NSA_KV_GROUPS, NSA_HEAD_DIM)
    for l in range(DEPTH):
        xn = rmsnorm(x, g_mix[l])
        proj = xn @ w_in[l]
        (q, kc, vc, ksl, vsl, kwn, vwn, nsa_g, glu_in, merge_g) = jnp.split(proj, split_pts, axis=-1)
        q = q.reshape(B, S, NSA_KV_GROUPS, NSA_HPG, NSA_HEAD_DIM)
        o_cmp, p_cmp, cmp_idx = nsa_compressed(q, kc.reshape(kv_shape), vc.reshape(kv_shape),
                                               pe_cmp_k[l], pe_cmp_v[l], w_cmp_k1[l], w_cmp_k2[l],
                                               w_cmp_v1[l], w_cmp_v2[l], slopes_gh)
        o_slc = nsa_selected(q, ksl.reshape(kv_shape), vsl.reshape(kv_shape), p_cmp, cmp_idx, slopes_gh)
        o_win = nsa_window(q, kwn.reshape(kv_shape), vwn.reshape(kv_shape), slopes_gh)
        gts = jax.nn.sigmoid(nsa_g).reshape(B, S, 3, NSA_KV_GROUPS, NSA_HPG, 1)
        o_nsa = gts[:, :, 0] * o_cmp + gts[:, :, 1] * o_slc + gts[:, :, 2] * o_win
        y_a = o_nsa.reshape(B, S, NSA_WIDTH) @ w_nsa_out[l]
        y_b = conformer_conv(glu_in, w_dw[l], b_dw[l], g_conv_ln[l], b_conv_ln[l]) @ w_conv_out[l]
        g_a, g_b = jnp.split(jax.nn.sigmoid(merge_g), 2, axis=-1)
        x = x + (g_a * y_a + g_b * y_b) @ w_o[l]
        x = x + peer_ffn(rmsnorm(x, g_ffn[l]), w_peer_q[l], peer_sub_keys[l], peer_u[l], peer_v[l])
    return rmsnorm(x, g_final)
```

```cpp
#include <hip/hip_runtime.h>
#include <hip/hip_cooperative_groups.h>
#include <cstdio>
namespace cg = cooperative_groups;

typedef unsigned short u16;
typedef unsigned long long u64;
typedef short bf16x8 __attribute__((ext_vector_type(8)));
typedef short s16x4 __attribute__((ext_vector_type(4)));
typedef float f32x16 __attribute__((ext_vector_type(16)));
typedef float f32x2_t __attribute__((ext_vector_type(2)));
typedef unsigned u32x4 __attribute__((ext_vector_type(4)));
typedef __bf16 bf16x2_t __attribute__((ext_vector_type(2)));

#define DI __device__ __forceinline__
#define MFMA32(a, b, c) __builtin_amdgcn_mfma_f32_32x32x16_bf16((a), (b), (c), 0, 0, 0)

constexpr int T_TOK = 16384;
constexpr int SEQ = 4096;
constexpr int NIN = 4608;
constexpr int HALF_LDS = 81664;
constexpr int DYN_LDS = 2 * HALF_LDS;
constexpr float LOG2E = 1.4426950408889634f;

constexpr size_t al256(size_t x) { return (x + 255) / 256 * 256; }
constexpr size_t WS_WT_IN   = 0;
constexpr size_t WS_WT_NSA  = al256(WS_WT_IN + (size_t)NIN * 1024 * 2);
constexpr size_t WS_WT_CONV = al256(WS_WT_NSA + 1024ull * 512 * 2);
constexpr size_t WS_WT_O    = al256(WS_WT_CONV + 1024ull * 512 * 2);
constexpr size_t WS_WT_PQ   = al256(WS_WT_O + 1024ull * 1024 * 2);
constexpr size_t WS_WT_C1   = al256(WS_WT_PQ + 2048ull * 1024 * 2);
constexpr size_t WS_SUBK    = al256(WS_WT_C1 + 128ull * 2048 * 2);
constexpr size_t WS_BIAS    = al256(WS_SUBK + 262144ull * 2);
constexpr size_t WS_UBF     = al256(WS_BIAS + 128 * 4);
constexpr size_t WS_VBF     = al256(WS_UBF + 16384ull * 1024 * 2);
constexpr size_t WS_XN      = al256(WS_VBF + 16384ull * 1024 * 2);
constexpr size_t WS_Q       = al256(WS_XN + 16384ull * 1024 * 2);
constexpr size_t WS_KC      = al256(WS_Q + 16384ull * 512 * 2);
constexpr size_t WS_VC      = al256(WS_KC + 16384ull * 128 * 2);
constexpr size_t WS_KS      = al256(WS_VC + 16384ull * 128 * 2);
constexpr size_t WS_KW      = al256(WS_KS + 16384ull * 128 * 2);
constexpr size_t WS_VTS     = al256(WS_KW + 16384ull * 128 * 2);
constexpr size_t WS_VTW     = al256(WS_VTS + 16384ull * 128 * 2);
constexpr size_t WS_KCMP    = al256(WS_VTW + 16384ull * 128 * 2);
constexpr size_t WS_VCMPT   = al256(WS_KCMP + 8ull * 256 * 64 * 2);
constexpr size_t WS_NG      = al256(WS_VCMPT + 8ull * 256 * 64 * 2);
constexpr size_t WS_GLU     = al256(WS_NG + 16384ull * 32 * 4);
constexpr size_t WS_MG      = al256(WS_GLU + 16384ull * 512 * 2);
constexpr size_t WS_END     = al256(WS_MG + 16384ull * 2048 * 2);
constexpr size_t WS_SU = WS_UBF + 16384ull * 1024;
constexpr size_t WS_SV = WS_VBF + 16384ull * 1024;
constexpr size_t WS_BAR = WS_END;
constexpr size_t WS_END2 = al256(WS_BAR + 3456 * 4);
static_assert(WS_END2 <= 256ull * 1024 * 1024, "workspace too big");
static_assert(WS_VTS - WS_Q == 16384ull * 1024 * 2, "xn2 alias region");

struct Params {
  const float *x, *g_mix, *w_in, *pe_k, *pe_v, *w_k1, *w_k2, *w_v1, *w_v2, *w_nsa_out, *w_dw, *b_dw, *g_ln, *b_ln,
      *w_conv_out, *w_o, *g_ffn, *w_pq, *subk, *pu, *pv, *g_final;
  float* out;
  char* ws;
};

DI u16 f2bf(float x) {
  unsigned u = __float_as_uint(x);
  u += 0x7fffu + ((u >> 16) & 1u);
  return (u16)(u >> 16);
}
DI unsigned pack2(float a, float b) {
  f32x2_t v = {a, b};
  bf16x2_t r = __builtin_convertvector(v, bf16x2_t);
  return __builtin_bit_cast(unsigned, r);
}
DI int my_tid() { int t = threadIdx.x & 255; asm volatile("" : "+v"(t)); return t; }
DI int tid512() { int t = threadIdx.x; asm volatile("" : "+v"(t)); return t; }
DI int half_id() { return __builtin_amdgcn_readfirstlane((int)(threadIdx.x >> 8)); }
DI int vb_id() { return (int)blockIdx.x + half_id() * (int)gridDim.x; }
DI int vb_n() { return (int)gridDim.x * 2; }
DI void hsync_impl(const bool INIT) {
  __shared__ unsigned hb[4];
  if (INIT) {
    hb[0] = 0u; hb[1] = 0u; hb[2] = 0u; hb[3] = 0u;
    return;
  }
  asm volatile("s_waitcnt vmcnt(0) lgkmcnt(0)" ::: "memory");
  if ((threadIdx.x & 63) == 0) {
    const int h2 = 2 * half_id();
    const unsigned gen = __hip_atomic_load(&hb[h2 + 1], __ATOMIC_RELAXED, __HIP_MEMORY_SCOPE_WORKGROUP);
    const unsigned old = __hip_atomic_fetch_add(&hb[h2], 1u, __ATOMIC_RELAXED, __HIP_MEMORY_SCOPE_WORKGROUP);
    if (old == 3u) {
      __hip_atomic_store(&hb[h2], 0u, __ATOMIC_RELAXED, __HIP_MEMORY_SCOPE_WORKGROUP);
      asm volatile("s_waitcnt vmcnt(0) lgkmcnt(0)" ::: "memory");
      __hip_atomic_fetch_add(&hb[h2 + 1], 1u, __ATOMIC_RELAXED, __HIP_MEMORY_SCOPE_WORKGROUP);
    } else {
      while (__hip_atomic_load(&hb[h2 + 1], __ATOMIC_RELAXED, __HIP_MEMORY_SCOPE_WORKGROUP) == gen) __builtin_amdgcn_s_sleep(1);
    }
  }
  asm volatile("s_waitcnt vmcnt(0) lgkmcnt(0)" ::: "memory");
}
DI void hsync() { hsync_impl(false); }
DI float bflo(unsigned u) { return __uint_as_float(u << 16); }
DI float bfhi(unsigned u) { return __uint_as_float(u & 0xffff0000u); }
DI float wave_sum(float v) {
#pragma unroll
  for (int o = 32; o > 0; o >>= 1) v += __shfl_xor(v, o);
  return v;
}
DI float sigmoidf_(float x) { return 1.f / (1.f + __expf(-x)); }
DI float gelu_exact(float x) { return 0.5f * x * (1.f + erff(x * 0.7071067811865476f)); }
DI float fexp2(float x) { return __builtin_amdgcn_exp2f(x); }
DI int swap23(int t) { return (t & ~12) | ((t & 4) << 1) | ((t & 8) >> 1); }
DI int crow(int i, int hh) { return (i & 3) + 8 * (i >> 2) + 4 * hh; }
DI unsigned f2ord(float f) {
  unsigned u = __float_as_uint(f);
  return (u & 0x80000000u) ? ~u : (u | 0x80000000u);
}
DI float ord2f(unsigned u) { return __uint_as_float((u & 0x80000000u) ? (u ^ 0x80000000u) : ~u); }

#define XB_TMO      128
#define XB_XCNT(j)  (256  + 64 * (j))
#define XB_XSUB(j)  (1280 + 64 * (j))
#define XB_XGEN(j)  (2304 + 64 * (j))
#define XB_TOP      3328
#define XB_TOPGEN   3392
#define XCD_BAR_WORDS 3456
#define XB_SPIN_CAP (1u << 18)
#define LAS __attribute__((address_space(3)))

__device__ __forceinline__ unsigned xb_ld(unsigned* p)              { return __hip_atomic_load(p, __ATOMIC_RELAXED, __HIP_MEMORY_SCOPE_AGENT); }
__device__ __forceinline__ unsigned xb_add(unsigned* p, unsigned v) { return __hip_atomic_fetch_add(p, v, __ATOMIC_RELAXED, __HIP_MEMORY_SCOPE_AGENT); }
__device__ __forceinline__ unsigned xb_xcc_id() { return (unsigned)__builtin_amdgcn_s_getreg((3 << 11) | 20) & 0xFu; }
#define XB_SPIN(cond, bar) do { unsigned _sp = 0; while (cond) { __builtin_amdgcn_s_sleep(1); \
    if ((++_sp & 255u) == 0u) { if (xb_ld(&(bar)[XB_TMO])) break; if (_sp > XB_SPIN_CAP) { atomicAdd(&(bar)[XB_TMO], 1u); break; } } } } while (0)

struct XcdBarrier {
    unsigned* bar; unsigned x;
    volatile LAS unsigned* st;
};

__device__ __forceinline__ XcdBarrier xcd_barrier_post(unsigned* bar, volatile LAS unsigned* st) {
    XcdBarrier b; b.bar = bar; b.x = xb_xcc_id(); b.st = st;
    if (threadIdx.x == 0) (void)xb_add(&bar[XB_XCNT(b.x)], 1u);
    return b;
}
__device__ __forceinline__ void xcd_barrier_complete(unsigned* bar, unsigned x, unsigned& nloc, unsigned& nx) {
    const unsigned G = gridDim.x * gridDim.y * gridDim.z;
    unsigned sum, cnt, mine, sp = 0u;
    for (;;) {
        sum = 0u; cnt = 0u; mine = 0u;
#pragma unroll
        for (unsigned j = 0; j < 16; ++j) { const unsigned c = xb_ld(&bar[XB_XCNT(j)]); sum += c; cnt += (c > 0u) ? 1u : 0u; mine = (j == x) ? c : mine; }
        if (sum == G) break;
        __builtin_amdgcn_s_sleep(1);
        if ((++sp & 255u) == 0u) { if (xb_ld(&bar[XB_TMO])) break; if (sp > XB_SPIN_CAP) { atomicAdd(&bar[XB_TMO], 1u); break; } }
    }
    nloc = mine > 0u ? mine : 1u; nx = cnt > 0u ? cnt : 1u;
}

__device__ __forceinline__ void xcd_barrier(const XcdBarrier& b) {
    asm volatile("s_waitcnt vmcnt(0)" ::: "memory");
    __syncthreads();
    if (threadIdx.x == 0) {
        unsigned* bar = b.bar;
        __builtin_amdgcn_s_waitcnt(0);
        unsigned nloc = b.st[0], nx = b.st[1];
        if (nloc == 0u) { xcd_barrier_complete(bar, b.x, nloc, nx); b.st[0] = nloc; b.st[1] = nx; }
        const unsigned old = xb_add(&bar[XB_XSUB(b.x)], 1u);
        const unsigned gen = old / nloc;
        if (old + 1u == (gen + 1u) * nloc) {
            __builtin_amdgcn_fence(__ATOMIC_RELEASE, "agent");
            asm volatile("s_waitcnt vmcnt(0)" ::: "memory");
            const unsigned og = xb_add(&bar[XB_TOP], 1u);
            const unsigned tg = og / nx;
            if (og + 1u == (tg + 1u) * nx) xb_add(&bar[XB_TOPGEN], 1u);
            else XB_SPIN(xb_ld(&bar[XB_TOPGEN]) == tg, bar);
            __builtin_amdgcn_fence(__ATOMIC_ACQUIRE, "agent");
            xb_add(&bar[XB_XGEN(b.x)], 1u);
            asm volatile("s_waitcnt vmcnt(0)" ::: "memory");
        } else {
            XB_SPIN(xb_ld(&bar[XB_XGEN(b.x)]) == gen, bar);
            __builtin_amdgcn_fence(__ATOMIC_ACQUIRE, "agent");
            asm volatile("s_waitcnt vmcnt(0)" ::: "memory");
        }
    }
    __syncthreads();
}


DI int inproj_colmap(int p) {
  if (p < 1280) return p;
  if (p < 2304) {
    int j = p - 1280;
    int blk = j >> 7, w = j & 127;
    return 1304 + (w < 64 ? blk * 64 + w : 512 + blk * 64 + (w - 64));
  }
  if (p < 4352) return 2328 + (p - 2304);
  if (p < 4376) return 1280 + (p - 4352);
  return -1;
}

template <bool MAPPED>
DI void transpose_tile(const float* __restrict__ W, int K, int N, u16* __restrict__ Wt, int kt, int nt, char* smem) {
  float* s = (float*)smem;
  const int tid = my_tid();
  hsync();
#pragma unroll 4
  for (int i = 0; i < 16; ++i) {
    int idx = tid + 256 * i;
    int kk = idx >> 6, pp = idx & 63;
    int pcol = nt * 64 + pp;
    int oc = MAPPED ? inproj_colmap(pcol) : pcol;
    float v = 0.f;
    if (oc >= 0) v = W[(size_t)(kt * 64 + kk) * N + oc];
    s[kk * 65 + pp] = v;
  }
  hsync();
#pragma unroll 4
  for (int i = 0; i < 16; ++i) {
    int idx = tid + 256 * i;
    int pp = idx >> 6, kk = idx & 63;
    Wt[(size_t)(nt * 64 + pp) * K + kt * 64 + kk] = f2bf(s[kk * 65 + pp]);
  }
}

DI void rms_row(const float* __restrict__ xr, const float* __restrict__ g, u16* __restrict__ dst, int lane) {
  float4 v[4];
  float ss = 0.f;
#pragma unroll
  for (int i = 0; i < 4; ++i) {
    v[i] = *(const float4*)(xr + lane * 4 + 256 * i);
    ss += v[i].x * v[i].x + v[i].y * v[i].y + v[i].z * v[i].z + v[i].w * v[i].w;
  }
  ss = wave_sum(ss);
  float r = rsqrtf(ss * (1.f / 1024.f) + 1e-6f);
#pragma unroll
  for (int i = 0; i < 4; ++i) {
    float4 gg = *(const float4*)(g + lane * 4 + 256 * i);
    uint2 o;
    o.x = pack2(v[i].x * r * gg.x, v[i].y * r * gg.y);
    o.y = pack2(v[i].z * r * gg.z, v[i].w * r * gg.w);
    *(uint2*)(dst + lane * 4 + 256 * i) = o;
  }
}

DI void convert_chunk(const float* __restrict__ src, u16* __restrict__ dst, int item) {
  const int tid = my_tid();
#pragma unroll
  for (int i = 0; i < 4; ++i) {
    size_t idx = (size_t)item * 8192 + i * 2048 + tid * 8;
    float4 a = *(const float4*)(src + idx);
    float4 b = *(const float4*)(src + idx + 4);
    uint4 o;
    o.x = pack2(a.x, a.y); o.y = pack2(a.z, a.w); o.z = pack2(b.x, b.y); o.w = pack2(b.z, b.w);
    *(uint4*)(dst + idx) = o;
  }
}

template <int NR>
DI void fp8_rows(const float* __restrict__ src, unsigned char* __restrict__ dst, float* __restrict__ scale_out, int lane) {
  float4 v[NR][4];
#pragma unroll
  for (int r = 0; r < NR; ++r)
#pragma unroll
    for (int i = 0; i < 4; ++i) v[r][i] = *(const float4*)(src + (size_t)r * 1024 + 256 * i + lane * 4);
#pragma unroll
  for (int r = 0; r < NR; ++r) {
    float amax = 0.f;
#pragma unroll
    for (int i = 0; i < 4; ++i)
      amax = fmaxf(amax, fmaxf(fmaxf(fabsf(v[r][i].x), fabsf(v[r][i].y)), fmaxf(fabsf(v[r][i].z), fabsf(v[r][i].w))));
#pragma unroll
    for (int o = 32; o > 0; o >>= 1) amax = fmaxf(amax, __shfl_xor(amax, o));
    const float scale = amax > 0.f ? amax * (1.f / 440.f) : 1.f;
    const float inv = 1.f / scale;
    u32x4 w;
#pragma unroll
    for (int i = 0; i < 4; ++i) {
      int t = 0;
      t = __builtin_amdgcn_cvt_pk_fp8_f32(v[r][i].x * inv, v[r][i].y * inv, t, false);
      t = __builtin_amdgcn_cvt_pk_fp8_f32(v[r][i].z * inv, v[r][i].w * inv, t, true);
      w[i] = (unsigned)t;
    }
    *(u32x4*)(dst + (size_t)r * 1024 + lane * 16) = w;
    if (lane == 0) scale_out[r] = scale;
  }
}

template <int NR>
DI void rms_rows(const float* __restrict__ xr, const float* __restrict__ g, u16* __restrict__ dst, int lane) {
  float4 v[NR][4];
#pragma unroll
  for (int r = 0; r < NR; ++r)
#pragma unroll
    for (int i = 0; i < 4; ++i) v[r][i] = *(const float4*)(xr + (size_t)r * 1024 + lane * 4 + 256 * i);
  float4 gg[4];
#pragma unroll
  for (int i = 0; i < 4; ++i) gg[i] = *(const float4*)(g + lane * 4 + 256 * i);
#pragma unroll
  for (int r = 0; r < NR; ++r) {
    float ss = 0.f;
#pragma unroll
    for (int i = 0; i < 4; ++i) ss += v[r][i].x * v[r][i].x + v[r][i].y * v[r][i].y + v[r][i].z * v[r][i].z + v[r][i].w * v[r][i].w;
    ss = wave_sum(ss);
    const float rr = rsqrtf(ss * (1.f / 1024.f) + 1e-6f);
#pragma unroll
    for (int i = 0; i < 4; ++i) {
      uint2 o;
      o.x = pack2(v[r][i].x * rr * gg[i].x, v[r][i].y * rr * gg[i].y);
      o.y = pack2(v[r][i].z * rr * gg[i].z, v[r][i].w * rr * gg[i].w);
      *(uint2*)(dst + (size_t)r * 1024 + lane * 4 + 256 * i) = o;
    }
  }
}

DI void phase_prep(const Params& p, char* smem, int part, int vb) {
  char* ws = p.ws;
  const int tid = my_tid(), lane = tid & 63, wave = tid >> 6;
  if (part == 0) {
    const int NITEMS = 1024 + 1152 + 64;
    for (int it0 = vb; it0 < NITEMS; it0 += vb_n()) {
      int it = it0;
      if (it < 1024) {
        int row = it * 16 + wave * 4;
        rms_rows<4>(p.x + (size_t)row * 1024, p.g_mix, (u16*)(ws + WS_XN) + (size_t)row * 1024, lane);
        continue;
      }
      it -= 1024;
      if (it < 1152) { transpose_tile<true>(p.w_in, 1024, 4376, (u16*)(ws + WS_WT_IN), it / 72, it % 72, smem); continue; }
      it -= 1152;
      {
        int kv = it >> 5, kt = it & 31;
        transpose_tile<false>(kv ? p.w_v1 : p.w_k1, 2048, 64, (u16*)(ws + WS_WT_C1) + (size_t)kv * 64 * 2048, kt, 0, smem);
      }
    }
  } else {
    const int NITEMS = 1024 + 1024 + 128 + 128 + 256 + 512 + 32;
    for (int it0 = vb; it0 < NITEMS; it0 += vb_n()) {
      int it = it0;
      if (it < 1024) {
        int row = it * 16 + wave * 4;
        fp8_rows<4>(p.pu + (size_t)row * 1024, (unsigned char*)(ws + WS_UBF) + (size_t)row * 1024, (float*)(ws + WS_SU) + row, lane);
        continue;
      }
      it -= 1024;
      if (it < 1024) {
        int row = it * 16 + wave * 4;
        fp8_rows<4>(p.pv + (size_t)row * 1024, (unsigned char*)(ws + WS_VBF) + (size_t)row * 1024, (float*)(ws + WS_SV) + row, lane);
        continue;
      }
      it -= 1024;
      if (it < 128) { transpose_tile<false>(p.w_nsa_out, 512, 1024, (u16*)(ws + WS_WT_NSA), it / 16, it % 16, smem); continue; }
      it -= 128;
      if (it < 128) { transpose_tile<false>(p.w_conv_out, 512, 1024, (u16*)(ws + WS_WT_CONV), it / 16, it % 16, smem); continue; }
      it -= 128;
      if (it < 256) { transpose_tile<false>(p.w_o, 1024, 1024, (u16*)(ws + WS_WT_O), it / 16, it % 16, smem); continue; }
      it -= 256;
      if (it < 512) { transpose_tile<false>(p.w_pq, 1024, 2048, (u16*)(ws + WS_WT_PQ), it / 32, it % 32, smem); continue; }
      it -= 512;
      convert_chunk(p.subk, (u16*)(ws + WS_SUBK), it);
    }
  }
}

template <int WM, class AF, class BF>
DI void gemm512(f32x16 (&acc)[WM][2], AF arow, int a_kstep, BF brow, int b_kstep, int KT, char* smem) {
  constexpr int AM = WM * 64;
  constexpr int NA = AM / 64;
  const int tid = tid512(), lane = tid & 63, wave = tid >> 6;
  const int wm = wave >> 2, wn = wave & 3, lr = lane & 31, hh = lane >> 5;
  const u16* ap[NA];
  const u16* bp[4];
  int soa[NA], sob[4];
#pragma unroll
  for (int i = 0; i < NA; ++i) {
    int c = tid + 512 * i;
    int row = c >> 3, kc = (c & 7) * 8;
    ap[i] = arow(row) + kc;
    soa[i] = row * 72 + kc;
  }
#pragma unroll
  for (int i = 0; i < 4; ++i) {
    int c = tid + 512 * i;
    int row = c >> 3, kc = (c & 7) * 8;
    bp[i] = brow(row) + kc;
    sob[i] = row * 72 + kc;
  }
  u32x4 ra0[NA], rb0[4], ra1[NA], rb1[4];
#pragma unroll
  for (int i = 0; i < NA; ++i) ra0[i] = *(const u32x4*)ap[i];
#pragma unroll
  for (int i = 0; i < 4; ++i) rb0[i] = *(const u32x4*)bp[i];
  {
    const int s1 = (KT > 1) ? 1 : 0;
#pragma unroll
    for (int i = 0; i < NA; ++i) ra1[i] = *(const u32x4*)(ap[i] + s1 * a_kstep);
#pragma unroll
    for (int i = 0; i < 4; ++i) rb1[i] = *(const u32x4*)(bp[i] + s1 * b_kstep);
  }
  u16* A0 = (u16*)smem;
  u16* B0 = A0 + AM * 72;
  u16* A1 = B0 + 256 * 72;
  u16* B1 = A1 + AM * 72;
  __syncthreads();
#pragma unroll
  for (int i = 0; i < NA; ++i) *(u32x4*)(A0 + soa[i]) = ra0[i];
#pragma unroll
  for (int i = 0; i < 4; ++i) *(u32x4*)(B0 + sob[i]) = rb0[i];
  __syncthreads();
  const int fa = (wm * WM * 32 + lr) * 72 + hh * 8, fb = (wn * 64 + lr) * 72 + hh * 8;
#define GEMM_STEP(AS, BS, AD, BD, RLA, RLB, RSA, RSB, SNEXT)                                      \
  {                                                                                              \
    const int sn = (SNEXT) < KT ? (SNEXT) : KT - 1;                                              \
    _Pragma("unroll") for (int i = 0; i < NA; ++i) RLA[i] = *(const u32x4*)(ap[i] + sn * a_kstep); \
    _Pragma("unroll") for (int i = 0; i < 4; ++i) RLB[i] = *(const u32x4*)(bp[i] + sn * b_kstep);  \
    _Pragma("unroll") for (int ks = 0; ks < 4; ++ks) {                                           \
      bf16x8 b0 = *(const bf16x8*)((BS) + fb + ks * 16);                                         \
      bf16x8 b1 = *(const bf16x8*)((BS) + fb + 32 * 72 + ks * 16);                               \
      _Pragma("unroll") for (int i = 0; i < WM; ++i) {                                           \
        bf16x8 a = *(const bf16x8*)((AS) + fa + i * 32 * 72 + ks * 16);                          \
        acc[i][0] = MFMA32(a, b0, acc[i][0]);                                                    \
        acc[i][1] = MFMA32(a, b1, acc[i][1]);                                                    \
      }                                                                                          \
    }                                                                                            \
    _Pragma("unroll") for (int i = 0; i < NA; ++i) *(u32x4*)((AD) + soa[i]) = RSA[i];            \
    _Pragma("unroll") for (int i = 0; i < 4; ++i) *(u32x4*)((BD) + sob[i]) = RSB[i];             \
    __syncthreads();                                                                             \
  }
#pragma unroll 1
  for (int kt = 0; kt < KT; kt += 2) {
    GEMM_STEP(A0, B0, A1, B1, ra0, rb0, ra1, rb1, kt + 2)
    if (kt + 1 < KT) GEMM_STEP(A1, B1, A0, B0, ra1, rb1, ra0, rb0, kt + 3)
  }
#undef GEMM_STEP
}

template <int WM>
DI void zero_acc(f32x16 (&acc)[WM][2]) {
#pragma unroll
  for (int i = 0; i < WM; ++i)
#pragma unroll
    for (int j = 0; j < 2; ++j)
#pragma unroll
      for (int e = 0; e < 16; ++e) acc[i][j][e] = 0.f;
}

DI bool xcd_tile(int k, int NT, int MPX, int& mt, int& nt) {
  const int x = blockIdx.x & 7, lb = blockIdx.x >> 3, nlb = gridDim.x >> 3;
  const int r = lb + nlb * k;
  if (r >= MPX * NT) return false;
  nt = r / MPX;
  mt = x * MPX + (r % MPX);
  return true;
}

template <int WM>
DI void inproj_tile(const Params& p, char* smem, const int m0, const int n0) {
  char* ws = p.ws;
  const u16* XN = (const u16*)(ws + WS_XN);
  const u16* WT = (const u16*)(ws + WS_WT_IN);
  u16* Q = (u16*)(ws + WS_Q);
  u16* KC = (u16*)(ws + WS_KC);
  u16* VC = (u16*)(ws + WS_VC);
  u16* KS = (u16*)(ws + WS_KS);
  u16* KW = (u16*)(ws + WS_KW);
  u16* VTS = (u16*)(ws + WS_VTS);
  u16* VTW = (u16*)(ws + WS_VTW);
  float* NG = (float*)(ws + WS_NG);
  u16* GLU = (u16*)(ws + WS_GLU);
  u16* MG = (u16*)(ws + WS_MG);
  const int tid = tid512(), lane = tid & 63, wave = tid >> 6;
  const int wm = wave >> 2, wn = wave & 3, lr = lane & 31, hh = lane >> 5;
  f32x16 acc[WM][2];
  zero_acc<WM>(acc);
  gemm512<WM>(acc, [&](int r) { return WT + (size_t)(n0 + r) * 1024; }, 64,
              [&](int r) { return XN + (size_t)(m0 + r) * 1024; }, 64, 16, smem);
  const int fw = n0 + wm * (WM * 32);
  const int tb = m0 + wn * 64 + lr;
  if (fw < 512) {
#pragma unroll
    for (int i = 0; i < WM; ++i)
#pragma unroll
      for (int j = 0; j < 2; ++j)
#pragma unroll
        for (int q4 = 0; q4 < 4; ++q4) {
          const int f = fw + i * 32 + q4 * 8 + hh * 4;
          const size_t t = tb + j * 32;
          const float sc = 0.125f * LOG2E;
          uint2 o;
          o.x = pack2(acc[i][j][q4 * 4 + 0] * sc, acc[i][j][q4 * 4 + 1] * sc);
          o.y = pack2(acc[i][j][q4 * 4 + 2] * sc, acc[i][j][q4 * 4 + 3] * sc);
          *(uint2*)(Q + t * 512 + f) = o;
        }
  } else if (fw < 1280) {
    const int sec = (fw - 512) >> 7;
    const int c0 = (fw - 512) & 127;
    if (sec == 3 || sec == 5) {
      u16* VT = (sec == 3) ? VTS : VTW;
#pragma unroll
      for (int i = 0; i < WM; ++i)
#pragma unroll
        for (int j = 0; j < 2; ++j)
#pragma unroll
          for (int e = 0; e < 16; ++e) {
            const int c = c0 + i * 32 + crow(e, hh);
            const int tt = tb + j * 32;
            const int b = tt >> 12, t = tt & 4095;
            VT[((size_t)(b * 128 + c)) * 4096 + swap23(t)] = f2bf(acc[i][j][e]);
          }
    } else {
      u16* dst = (sec == 0) ? KC : (sec == 1) ? VC : (sec == 2) ? KS : KW;
#pragma unroll
      for (int i = 0; i < WM; ++i)
#pragma unroll
        for (int j = 0; j < 2; ++j)
#pragma unroll
          for (int q4 = 0; q4 < 4; ++q4) {
            const int c = c0 + i * 32 + q4 * 8 + hh * 4;
            const size_t t = tb + j * 32;
            uint2 o;
            o.x = pack2(acc[i][j][q4 * 4 + 0], acc[i][j][q4 * 4 + 1]);
            o.y = pack2(acc[i][j][q4 * 4 + 2], acc[i][j][q4 * 4 + 3]);
            *(uint2*)(dst + t * 128 + c) = o;
          }
    }
  } else if (fw < 2304) {
    if (WM == 4) {
      const int blk = (fw - 1280) >> 7;
#pragma unroll
      for (int i = 0; i < 2; ++i)
#pragma unroll
        for (int j = 0; j < 2; ++j)
#pragma unroll
          for (int q4 = 0; q4 < 4; ++q4) {
            const int ch = blk * 64 + i * 32 + q4 * 8 + hh * 4;
            const size_t t = tb + j * 32;
            float u[4];
#pragma unroll
            for (int z = 0; z < 4; ++z) u[z] = acc[i][j][q4 * 4 + z] * sigmoidf_(acc[(i + 2) & (WM - 1)][j][q4 * 4 + z]);
            uint2 o;
            o.x = pack2(u[0], u[1]);
            o.y = pack2(u[2], u[3]);
            *(uint2*)(GLU + t * 512 + ch) = o;
          }
    }
  } else if (fw < 4352) {
#pragma unroll
    for (int i = 0; i < WM; ++i)
#pragma unroll
      for (int j = 0; j < 2; ++j)
#pragma unroll
        for (int q4 = 0; q4 < 4; ++q4) {
          const int f = fw - 2304 + i * 32 + q4 * 8 + hh * 4;
          const size_t t = tb + j * 32;
          uint2 o;
          o.x = pack2(sigmoidf_(acc[i][j][q4 * 4 + 0]), sigmoidf_(acc[i][j][q4 * 4 + 1]));
          o.y = pack2(sigmoidf_(acc[i][j][q4 * 4 + 2]), sigmoidf_(acc[i][j][q4 * 4 + 3]));
          *(uint2*)(MG + t * 2048 + f) = o;
        }
  } else if (fw == 4352) {
#pragma unroll
    for (int j = 0; j < 2; ++j)
#pragma unroll
      for (int q4 = 0; q4 < 3; ++q4) {
        const int f = q4 * 8 + hh * 4;
        const size_t t = tb + j * 32;
        float4 o;
        o.x = sigmoidf_(acc[0][j][q4 * 4 + 0]); o.y = sigmoidf_(acc[0][j][q4 * 4 + 1]);
        o.z = sigmoidf_(acc[0][j][q4 * 4 + 2]); o.w = sigmoidf_(acc[0][j][q4 * 4 + 3]);
        *(float4*)(NG + t * 32 + f) = o;
      }
  }
}

DI void phase_inproj(const Params& p, char* smem) {
  const int NT = NIN / 256;
  if (gridDim.x == 256) {
    const int x = blockIdx.x & 7, lb = blockIdx.x >> 3;
#pragma unroll 1
    for (int k = 0; k < 4; ++k) {
      const int r = lb + 32 * k;
      inproj_tile<4>(p, smem, (x * 8 + (r & 7)) * 256, (r >> 3) * 256);
    }
    const int r2 = 128 + (lb >> 1);
    inproj_tile<2>(p, smem, (x * 8 + (r2 & 7)) * 256, (r2 >> 3) * 256 + (lb & 1) * 128);
  } else {
    for (int kk = 0;; ++kk) {
      int mt, nt;
      if (!xcd_tile(kk, NT, 8, mt, nt)) break;
      inproj_tile<4>(p, smem, mt * 256, nt * 256);
    }
  }
}

DI void phase_compress(const Params& p, char* smem) {
  char* ws = p.ws;
  const u16* KC = (const u16*)(ws + WS_KC);
  const u16* VC = (const u16*)(ws + WS_VC);
  const u16* WT = (const u16*)(ws + WS_WT_C1);
  u16* KCMP = (u16*)(ws + WS_KCMP);
  u16* VCMPT = (u16*)(ws + WS_VCMPT);
  float* Hs = (float*)smem;
  const int tid = my_tid(), lane = tid & 63, wave = tid >> 6;
  const int lr = lane & 31, hh = lane >> 5;
  for (int it = vb_id(); it < 128; it += vb_n()) {
    const int kv = it & 1, mt = it >> 1;
    const u16* SRC = kv ? VC : KC;
    const float* pe = kv ? p.pe_v : p.pe_k;
    int mi = mt * 32 + lr;
    int bg = mi >> 8, n = mi & 255;
    if (n > 254) n = 254;
    const u16* arow = SRC + ((size_t)((bg >> 1) * 4096 + 16 * n)) * 128 + (bg & 1) * 64 + hh * 8;
    const u16* brow0 = WT + ((size_t)(kv * 64 + lr)) * 2048 + hh * 8;
    const u16* brow1 = brow0 + (size_t)32 * 2048;
    f32x16 acc0, acc1;
#pragma unroll
    for (int e = 0; e < 16; ++e) { acc0[e] = 0.f; acc1[e] = 0.f; }
#pragma unroll 4
    for (int sI = 0; sI < 32; ++sI) {
      const int s_ = wave * 32 + sI;
      const int l = s_ >> 2, d0 = (s_ & 3) * 16;
      u32x4 ar = *(const u32x4*)(arow + l * 128 + d0);
      float4 p0 = *(const float4*)(pe + l * 64 + d0 + hh * 8);
      float4 p1 = *(const float4*)(pe + l * 64 + d0 + hh * 8 + 4);
      bf16x8 b0 = *(const bf16x8*)(brow0 + s_ * 16);
      bf16x8 b1 = *(const bf16x8*)(brow1 + s_ * 16);
      u32x4 aw;
      aw[0] = pack2(bflo(ar[0]) + p0.x, bfhi(ar[0]) + p0.y);
      aw[1] = pack2(bflo(ar[1]) + p0.z, bfhi(ar[1]) + p0.w);
      aw[2] = pack2(bflo(ar[2]) + p1.x, bfhi(ar[2]) + p1.y);
      aw[3] = pack2(bflo(ar[3]) + p1.z, bfhi(ar[3]) + p1.w);
      bf16x8 a = __builtin_bit_cast(bf16x8, aw);
      acc0 = MFMA32(a, b0, acc0);
      acc1 = MFMA32(a, b1, acc1);
    }
    hsync();
#pragma unroll
    for (int e = 0; e < 16; ++e) {
      Hs[(wave * 32 + crow(e, hh)) * 65 + lr] = acc0[e];
      Hs[(wave * 32 + crow(e, hh)) * 65 + 32 + lr] = acc1[e];
    }
    hsync();
    const int row = tid >> 3, c0 = (tid & 7) * 8;
#pragma unroll
    for (int c = 0; c < 8; ++c) {
      float h = Hs[row * 65 + c0 + c] + Hs[(32 + row) * 65 + c0 + c] + Hs[(64 + row) * 65 + c0 + c] + Hs[(96 + row) * 65 + c0 + c];
      Hs[row * 65 + c0 + c] = gelu_exact(h);
    }
    hsync();
    {
      const float* w2 = kv ? p.w_v2 : p.w_k2;
      float o[8];
#pragma unroll
      for (int c = 0; c < 8; ++c) o[c] = 0.f;
#pragma unroll 8
      for (int i = 0; i < 64; ++i) {
        float hv = Hs[row * 65 + i];
        float4 wa = *(const float4*)(w2 + i * 64 + c0);
        float4 wb = *(const float4*)(w2 + i * 64 + c0 + 4);
        o[0] += hv * wa.x; o[1] += hv * wa.y; o[2] += hv * wa.z; o[3] += hv * wa.w;
        o[4] += hv * wb.x; o[5] += hv * wb.y; o[6] += hv * wb.z; o[7] += hv * wb.w;
      }
      int mi2 = mt * 32 + row;
      int bg2 = mi2 >> 8, n2 = mi2 & 255;
      if (n2 == 255) {
#pragma unroll
        for (int c = 0; c < 8; ++c) o[c] = 0.f;
      }
      if (kv == 0) {
        u32x4 w;
        w[0] = pack2(o[0], o[1]); w[1] = pack2(o[2], o[3]); w[2] = pack2(o[4], o[5]); w[3] = pack2(o[6], o[7]);
        *(u32x4*)(KCMP + ((size_t)(bg2 * 256 + n2)) * 64 + c0) = w;
      } else {
#pragma unroll
        for (int c = 0; c < 8; ++c) VCMPT[((size_t)(bg2 * 64 + c0 + c)) * 256 + swap23(n2)] = f2bf(o[c]);
      }
    }
    hsync();
  }
}

template <int KSTRIDE, bool WIN, int MASK, int MODE>
DI void attend_tile(const u16* Ks, const u16* Vts, const bf16x8 (&qf)[4], f32x16 (&O)[2], float& m, float& l, int dbase,
                    float slope2, bool lanesel, float invl, unsigned* imp_row, int mbase, int lr, int hh) {
  f32x16 s[2];
#pragma unroll
  for (int kt = 0; kt < 2; ++kt) {
#pragma unroll
    for (int e = 0; e < 16; ++e) s[kt][e] = 0.f;
#pragma unroll
    for (int ks = 0; ks < 4; ++ks) {
      bf16x8 a = *(const bf16x8*)(Ks + (kt * 32 + lr) * 72 + ks * 16 + hh * 8);
      s[kt] = MFMA32(a, qf[ks], s[kt]);
    }
  }
  const float fd0 = (float)(dbase - KSTRIDE * 4 * hh);
  const float ct = slope2 * fd0;
  float mx = -1e30f;
#pragma unroll
  for (int kt = 0; kt < 2; ++kt)
#pragma unroll
    for (int e = 0; e < 16; ++e) {
      const float Ke = (float)(KSTRIDE * (kt * 32 + (e & 3) + 8 * (e >> 2)));
      float v = fmaf(slope2, Ke, s[kt][e]);
      if (MASK == 1) {
        const float fd = fd0 - Ke;
        bool valid = fd >= 0.f;
        if (WIN) valid = valid && (fd < 512.f);
        valid = valid && lanesel;
        v = valid ? v : -1e30f;
      }
      s[kt][e] = v;
      mx = fmaxf(mx, v);
    }
  mx = (mx > -1e29f) ? mx - ct : -1e30f;
  mx = fmaxf(mx, __shfl_xor(mx, 32));
  if (MASK == 2) mx = lanesel ? mx : -1e30f;
  float mnew = m, alpha = 1.f;
  if (MODE != 2) {
    mnew = fmaxf(m, mx);
    alpha = fexp2(m - mnew);
    m = mnew;
  }
  float shift = mnew + ct;
  if (MASK == 2) shift = lanesel ? shift : 1e30f;
  float rs = 0.f;
#pragma unroll
  for (int kt = 0; kt < 2; ++kt)
#pragma unroll
    for (int e = 0; e < 16; ++e) {
      float v = s[kt][e];
      float pv;
      if (MASK == 1) pv = (v > -1e29f) ? fexp2(v - shift) : 0.f;
      else pv = fexp2(v - shift);
      if (MODE == 2) pv *= invl;
      s[kt][e] = pv;
      rs += pv;
    }
  if (MODE != 2) l = l * alpha + rs;
  if (MODE == 1) return;
  if (MODE == 0) {
#pragma unroll
    for (int e = 0; e < 16; ++e) { O[0][e] *= alpha; O[1][e] *= alpha; }
  }
  if (MODE == 2) {
#pragma unroll
    for (int kt = 0; kt < 2; ++kt)
#pragma unroll
      for (int q4 = 0; q4 < 4; ++q4) {
        float qsum = s[kt][q4 * 4] + s[kt][q4 * 4 + 1] + s[kt][q4 * 4 + 2] + s[kt][q4 * 4 + 3];
        float last = s[kt][q4 * 4 + 3];
        int mi = mbase + kt * 8 + 2 * q4 + hh;
        atomicAdd(imp_row + mi, (unsigned)(qsum * 1048576.f + 0.5f));
        if (mi + 1 < 64) atomicAdd(imp_row + mi + 1, (unsigned)(last * 1048576.f + 0.5f));
      }
  }
#pragma unroll
  for (int kt = 0; kt < 2; ++kt)
#pragma unroll
    for (int sx = 0; sx < 2; ++sx) {
      unsigned pk[4];
#pragma unroll
      for (int q = 0; q < 4; ++q) pk[q] = pack2(s[kt][8 * sx + 2 * q], s[kt][8 * sx + 2 * q + 1]);
      bf16x8 pb;
      {
        u32x4 t4 = {pk[0], pk[1], pk[2], pk[3]};
        pb = __builtin_bit_cast(bf16x8, t4);
      }
#pragma unroll
      for (int dt = 0; dt < 2; ++dt) {
        bf16x8 a = *(const bf16x8*)(Vts + (dt * 32 + lr) * 72 + kt * 32 + 16 * sx + 8 * hh);
        O[dt] = MFMA32(a, pb, O[dt]);
      }
    }
}

struct KVRegs { u32x4 k[2], v[2]; };
DI void kv_issue(KVRegs& r, const u16* ksrc, int kstride, const u16* vsrc, int vstride, int tid) {
#pragma unroll
  for (int i = 0; i < 2; ++i) {
    int c = tid + 256 * i;
    int row = c >> 3, ch = (c & 7) * 8;
    r.k[i] = *(const u32x4*)(ksrc + (size_t)row * kstride + ch);
    r.v[i] = *(const u32x4*)(vsrc + (size_t)row * vstride + ch);
  }
}
DI void kv_commit(const KVRegs& r, u16* Ks, u16* Vts, int tid) {
#pragma unroll
  for (int i = 0; i < 2; ++i) {
    int c = tid + 256 * i;
    int row = c >> 3, ch = (c & 7) * 8;
    *(u32x4*)(Ks + row * 72 + ch) = r.k[i];
    *(u32x4*)(Vts + row * 72 + ch) = r.v[i];
  }
  hsync();
}

DI void attn_item(const Params& p, int item, char* smem) {
  char* ws = p.ws;
  const u16* Q = (const u16*)(ws + WS_Q);
  const u16* KS = (const u16*)(ws + WS_KS);
  const u16* KW = (const u16*)(ws + WS_KW);
  const u16* VTS = (const u16*)(ws + WS_VTS);
  const u16* VTW = (const u16*)(ws + WS_VTW);
  const u16* KCMP = (const u16*)(ws + WS_KCMP);
  const u16* VCMPT = (const u16*)(ws + WS_VCMPT);
  const float* NG = (const float*)(ws + WS_NG);
  u16* ONSA = (u16*)p.out;

  u16* KsB = (u16*)smem;
  int pb = 0;
#define Ks (KsB + pb * (2 * 64 * 72))
#define Vts (KsB + pb * (2 * 64 * 72) + 64 * 72)
  unsigned* imp_s = (unsigned*)(KsB + 4 * 64 * 72);
  unsigned char* sel8 = (unsigned char*)(imp_s + 32 * 65);

  const int tid = my_tid(), lane = tid & 63, wave = tid >> 6;
  const int lr = lane & 31, hh = lane >> 5;
  const int bg = item & 7, q32 = 127 - (item >> 3);
  const int b = bg >> 1, g = bg & 1;
  const int t0 = q32 * 32;
  const int head = g * 4 + wave;
  const int t = t0 + lr;
  const size_t row = (size_t)b * 4096 + t;
  const int qb = t0 >> 6;

  bf16x8 qf[4];
#pragma unroll
  for (int ks = 0; ks < 4; ++ks) qf[ks] = *(const bf16x8*)(Q + row * 512 + head * 64 + ks * 16 + hh * 8);
  float* ot_s = (float*)(sel8 + 256) + wave * 32 * 64 + lane;
  const float slope2 = fexp2(-(float)(head + 1)) * LOG2E;
  const float gc = NG[row * 32 + head], gs = NG[row * 32 + 8 + head], gw = NG[row * 32 + 16 + head];

  f32x16 O[2];

  hsync();
  for (int i = tid; i < 32 * 65; i += 256) imp_s[i] = 0u;

  const int nct = t0 / 1024 + 1;
  float m = -1e30f, l = 0.f;
  KVRegs kvr;
  kv_issue(kvr, KCMP + ((size_t)(bg * 256)) * 64, 64, VCMPT + (size_t)bg * 64 * 256, 256, tid);
#pragma unroll 1
  for (int c = 0; c < nct; ++c) {
    kv_commit(kvr, Ks, Vts, tid);
    const int cn = (c + 1 < nct) ? c + 1 : 0;
    kv_issue(kvr, KCMP + ((size_t)(bg * 256 + 64 * cn)) * 64, 64, VCMPT + (size_t)bg * 64 * 256 + 64 * cn, 256, tid);
    attend_tile<16, false, 1, 1>(Ks, Vts, qf, O, m, l, t - (31 + 1024 * c), slope2, true, 0.f, nullptr, 0, lr, hh);
    pb ^= 1;
  }
  {
    float lt = l + __shfl_xor(l, 32);
    float invl = lt > 0.f ? 1.f / lt : 0.f;
#pragma unroll
    for (int e = 0; e < 16; ++e) { O[0][e] = 0.f; O[1][e] = 0.f; }
#pragma unroll 1
    for (int c = 0; c < nct; ++c) {
      kv_commit(kvr, Ks, Vts, tid);
      if (c + 1 < nct) kv_issue(kvr, KCMP + ((size_t)(bg * 256 + 64 * (c + 1))) * 64, 64, VCMPT + (size_t)bg * 64 * 256 + 64 * (c + 1), 256, tid);
      attend_tile<16, false, 1, 2>(Ks, Vts, qf, O, m, l, t - (31 + 1024 * c), slope2, true, invl, imp_s + lr * 65,
                                        c * 16, lr, hh);
      pb ^= 1;
    }
#pragma unroll
    for (int e = 0; e < 16; ++e) { ot_s[e * 64] = O[0][e] * gc; ot_s[(16 + e) * 64] = O[1][e] * gc; }
  }
  hsync();
  {
    const int tl = tid >> 3, part = tid & 7;
    unsigned bits = 0;
    if (qb <= 15) {
#pragma unroll
      for (int jj = 0; jj < 8; ++jj) if (part * 8 + jj <= qb) bits |= 1u << jj;
    } else {
      unsigned mine[8];
      int cnt[8];
#pragma unroll
      for (int jj = 0; jj < 8; ++jj) { mine[jj] = (imp_s[tl * 65 + part * 8 + jj] << 6) | (unsigned)(63 - (part * 8 + jj)); cnt[jj] = 0; }
      for (int jp = 1; jp <= qb - 2; ++jp) {
        const unsigned v = (imp_s[tl * 65 + jp] << 6) | (unsigned)(63 - jp);
#pragma unroll
        for (int jj = 0; jj < 8; ++jj) cnt[jj] += (v > mine[jj]) ? 1 : 0;
      }
#pragma unroll
      for (int jj = 0; jj < 8; ++jj) {
        int j = part * 8 + jj;
        bool f = (j == 0) || (j == qb) || (j == qb - 1);
        bool c = (j >= 1) && (j <= qb - 2) && (cnt[jj] < 13);
        if (f || c) bits |= 1u << jj;
      }
    }
    sel8[tl * 8 + part] = (unsigned char)bits;
  }
  hsync();
  {
    const unsigned* sel32 = (const unsigned*)sel8;
    const unsigned mylo = sel32[lr * 2], myhi = sel32[lr * 2 + 1];
    unsigned alo = mylo, ahi = myhi;
#pragma unroll
    for (int o = 16; o > 0; o >>= 1) { alo |= __shfl_xor(alo, o); ahi |= __shfl_xor(ahi, o); }
    alo = __builtin_amdgcn_readfirstlane(alo);
    ahi = __builtin_amdgcn_readfirstlane(ahi);
    m = -1e30f; l = 0.f;
#pragma unroll
    for (int e = 0; e < 16; ++e) { O[0][e] = 0.f; O[1][e] = 0.f; }
    u64 am = ((u64)ahi << 32) | (u64)alo;
    int j = -1;
    if (am) { j = __builtin_ctzll(am); am &= am - 1; }
    if (j >= 0) kv_issue(kvr, KS + ((size_t)(b * 4096 + 64 * j)) * 128 + g * 64, 128, VTS + (size_t)bg * 64 * 4096 + 64 * j, 4096, tid);
#pragma unroll 1
    while (j >= 0) {
      kv_commit(kvr, Ks, Vts, tid);
      int jn = -1;
      if (am) { jn = __builtin_ctzll(am); am &= am - 1; }
      if (jn >= 0) kv_issue(kvr, KS + ((size_t)(b * 4096 + 64 * jn)) * 128 + g * 64, 128, VTS + (size_t)bg * 64 * 4096 + 64 * jn, 4096, tid);
      bool ls = (j < 32) ? ((mylo >> j) & 1u) : ((myhi >> (j - 32)) & 1u);
      if (j < qb) attend_tile<1, false, 2, 0>(Ks, Vts, qf, O, m, l, t - 64 * j, slope2, ls, 0.f, nullptr, 0, lr, hh);
      else attend_tile<1, false, 1, 0>(Ks, Vts, qf, O, m, l, t - 64 * j, slope2, ls, 0.f, nullptr, 0, lr, hh);
      pb ^= 1;
      j = jn;
    }
    float lt = l + __shfl_xor(l, 32);
    float sc = lt > 0.f ? gs / lt : 0.f;
#pragma unroll
    for (int e = 0; e < 16; ++e) { ot_s[e * 64] += O[0][e] * sc; ot_s[(16 + e) * 64] += O[1][e] * sc; }
  }
  {
    m = -1e30f; l = 0.f;
#pragma unroll
    for (int e = 0; e < 16; ++e) { O[0][e] = 0.f; O[1][e] = 0.f; }
    const int kbase = (t0 & ~63) - 512;
    int i0 = 0;
    if (kbase < 0) i0 = (-kbase) >> 6;
    kv_issue(kvr, KW + ((size_t)(b * 4096 + kbase + 64 * i0)) * 128 + g * 64, 128, VTW + (size_t)bg * 64 * 4096 + kbase + 64 * i0, 4096, tid);
#pragma unroll 1
    for (int i = i0; i < 9; ++i) {
      const int k0 = kbase + 64 * i;
      kv_commit(kvr, Ks, Vts, tid);
      if (i + 1 < 9) kv_issue(kvr, KW + ((size_t)(b * 4096 + k0 + 64)) * 128 + g * 64, 128, VTW + (size_t)bg * 64 * 4096 + k0 + 64, 4096, tid);
      if (i >= 1 && i <= 7) attend_tile<1, false, 0, 0>(Ks, Vts, qf, O, m, l, t - k0, slope2, true, 0.f, nullptr, 0, lr, hh);
      else attend_tile<1, true, 1, 0>(Ks, Vts, qf, O, m, l, t - k0, slope2, true, 0.f, nullptr, 0, lr, hh);
      pb ^= 1;
    }
    float lt = l + __shfl_xor(l, 32);
    float sc = lt > 0.f ? gw / lt : 0.f;
#pragma unroll
    for (int e = 0; e < 16; ++e) { O[0][e] = ot_s[e * 64] + O[0][e] * sc; O[1][e] = ot_s[(16 + e) * 64] + O[1][e] * sc; }
  }
#pragma unroll
  for (int dt = 0; dt < 2; ++dt)
#pragma unroll
    for (int q4 = 0; q4 < 4; ++q4) {
      int d0 = dt * 32 + q4 * 8 + hh * 4;
      uint2 o;
      o.x = pack2(O[dt][q4 * 4 + 0], O[dt][q4 * 4 + 1]);
      o.y = pack2(O[dt][q4 * 4 + 2], O[dt][q4 * 4 + 3]);
      *(uint2*)(ONSA + row * 512 + head * 64 + d0) = o;
    }
  hsync();
}

#undef Ks
#undef Vts

DI void conv_item(const Params& p, int item, char* smem) {
  char* ws = p.ws;
  const u16* GLU = (const u16*)(ws + WS_GLU);
  u16* CACT = (u16*)p.out + (size_t)T_TOK * 512;
  float* cs = (float*)smem;
  const int tid = my_tid(), lane = tid & 63, wave = tid >> 6;
  const int b = item >> 8, t0 = (item & 255) * 16;
  const int c0 = tid * 2;
  const float2 bias = *(const float2*)(p.b_dw + c0);
  unsigned rowv[46];
#pragma unroll
  for (int r = 0; r < 46; ++r) {
    int tt = t0 - 30 + r;
    rowv[r] = 0u;
    if (tt >= 0) rowv[r] = *(const unsigned*)(GLU + ((size_t)(b * 4096 + tt)) * 512 + c0);
  }
  hsync();
#pragma unroll
  for (int pass = 0; pass < 2; ++pass) {
    float w[31];
#pragma unroll
    for (int k = 0; k < 31; ++k) w[k] = p.w_dw[k * 512 + c0 + pass];
#pragma unroll
    for (int tl = 0; tl < 16; ++tl) {
      float a0 = pass ? bias.y : bias.x;
#pragma unroll
      for (int k = 0; k < 31; ++k) a0 += w[k] * (pass ? bfhi(rowv[tl + k]) : bflo(rowv[tl + k]));
      cs[tl * 520 + c0 + pass] = a0;
    }
  }
  hsync();
#pragma unroll
  for (int q = 0; q < 4; ++q) {
    const int tl = wave * 4 + q;
    float v[8];
    float sum = 0.f;
#pragma unroll
    for (int i = 0; i < 8; ++i) { v[i] = cs[tl * 520 + lane + 64 * i]; sum += v[i]; }
    float mean = wave_sum(sum) * (1.f / 512.f);
    float sq = 0.f;
#pragma unroll
    for (int i = 0; i < 8; ++i) { float d = v[i] - mean; sq += d * d; }
    float rstd = rsqrtf(wave_sum(sq) * (1.f / 512.f) + 1e-6f);
#pragma unroll
    for (int i = 0; i < 8; ++i) {
      int c = lane + 64 * i;
      float y = (v[i] - mean) * rstd * p.g_ln[c] + p.b_ln[c];
      float sl = y * sigmoidf_(y);
      CACT[((size_t)(b * 4096 + t0 + tl)) * 512 + c] = f2bf(sl);
    }
  }
  hsync();
}

DI void phase_mix(const Params& p, char* smem) {
  {
    int rnd = 0;
    for (int it = vb_id(); it < 1024; it += vb_n(), ++rnd) {
      const int item = (rnd & 1) ? (1023 - (it - rnd * vb_n())) - ((rnd - 1) * vb_n()) : it;
      if (item >= 0 && item < 1024) attn_item(p, item, smem);
    }
  }
  for (int it = vb_id(); it < 1024; it += vb_n()) conv_item(p, it, smem);
}

DI void phase_merge(const Params& p, char* smem) {
  char* ws = p.ws;
  const u16* ONSA = (const u16*)p.out;
  const u16* CACT = (const u16*)p.out + (size_t)T_TOK * 512;
  const u16* WA = (const u16*)(ws + WS_WT_NSA);
  const u16* WB = (const u16*)(ws + WS_WT_CONV);
  const u16* MG = (const u16*)(ws + WS_MG);
  u16* MERGED = (u16*)(ws + WS_XN);
  const int tid = tid512(), lane = tid & 63, wave = tid >> 6;
  const int wm = wave >> 2, wn = wave & 3, lr = lane & 31, hh = lane >> 5;
  for (int kk = 0;; ++kk) {
    int mt, nt;
    if (!xcd_tile(kk, 8, 8, mt, nt)) break;
    const int m0 = mt * 256, n0 = nt * 128;
    f32x16 ya[2][2], yb[2][2];
    zero_acc<2>(ya);
    zero_acc<2>(yb);
    gemm512<2>(ya, [&](int r) { return WA + (size_t)(n0 + r) * 512; }, 64, [&](int r) { return ONSA + (size_t)(m0 + r) * 512; }, 64, 8, smem);
    gemm512<2>(yb, [&](int r) { return WB + (size_t)(n0 + r) * 512; }, 64, [&](int r) { return CACT + (size_t)(m0 + r) * 512; }, 64, 8, smem);
#pragma unroll
    for (int i = 0; i < 2; ++i)
#pragma unroll
      for (int j = 0; j < 2; ++j)
#pragma unroll
        for (int q4 = 0; q4 < 4; ++q4) {
          const int f = n0 + wm * 64 + i * 32 + q4 * 8 + hh * 4;
          const size_t t = m0 + wn * 64 + j * 32 + lr;
          const uint2 ga = *(const uint2*)(MG + t * 2048 + f);
          const uint2 gb = *(const uint2*)(MG + t * 2048 + 1024 + f);
          uint2 o;
          o.x = pack2(bflo(ga.x) * ya[i][j][q4 * 4 + 0] + bflo(gb.x) * yb[i][j][q4 * 4 + 0],
                      bfhi(ga.x) * ya[i][j][q4 * 4 + 1] + bfhi(gb.x) * yb[i][j][q4 * 4 + 1]);
          o.y = pack2(bflo(ga.y) * ya[i][j][q4 * 4 + 2] + bflo(gb.y) * yb[i][j][q4 * 4 + 2],
                      bfhi(ga.y) * ya[i][j][q4 * 4 + 3] + bfhi(gb.y) * yb[i][j][q4 * 4 + 3]);
          *(uint2*)(MERGED + t * 1024 + f) = o;
        }
  }
}

DI void phase_wo(const Params& p, char* smem) {
  char* ws = p.ws;
  const u16* MERGED = (const u16*)(ws + WS_XN);
  const u16* WT = (const u16*)(ws + WS_WT_O);
  float* X1 = p.out;
  const int tid = tid512(), lane = tid & 63, wave = tid >> 6;
  const int wm = wave >> 2, wn = wave & 3, lr = lane & 31, hh = lane >> 5;
  for (int kk = 0;; ++kk) {
    int mt, nt;
    if (!xcd_tile(kk, 4, 8, mt, nt)) break;
    const int m0 = mt * 256, n0 = nt * 256;
    f32x16 acc[4][2];
    zero_acc<4>(acc);
    gemm512<4>(acc, [&](int r) { return WT + (size_t)(n0 + r) * 1024; }, 64, [&](int r) { return MERGED + (size_t)(m0 + r) * 1024; }, 64, 16, smem);
#pragma unroll
    for (int i = 0; i < 4; ++i)
#pragma unroll
      for (int j = 0; j < 2; ++j)
#pragma unroll
        for (int q4 = 0; q4 < 4; ++q4) {
          const int f = n0 + wm * 128 + i * 32 + q4 * 8 + hh * 4;
          const size_t t = m0 + wn * 64 + j * 32 + lr;
          float4 xv = *(const float4*)(p.x + t * 1024 + f);
          xv.x += acc[i][j][q4 * 4 + 0]; xv.y += acc[i][j][q4 * 4 + 1];
          xv.z += acc[i][j][q4 * 4 + 2]; xv.w += acc[i][j][q4 * 4 + 3];
          *(float4*)(X1 + t * 1024 + f) = xv;
        }
  }
}

DI void phase_norm2(const Params& p) {
  const int tid = my_tid(); const int lane = tid & 63, wave = tid >> 6;
  u16* XN2 = (u16*)(p.ws + WS_Q);
  for (int it = vb_id(); it < 1024; it += vb_n()) {
    int row = it * 16 + wave * 4;
    rms_rows<4>(p.out + (size_t)row * 1024, p.g_ffn, XN2 + (size_t)row * 1024, lane);
  }
}

DI void phase_pq(const Params& p, char* smem) {
  char* ws = p.ws;
  const u16* XN2 = (const u16*)(ws + WS_Q);
  const u16* WT = (const u16*)(ws + WS_WT_PQ);
  u16* PQ = (u16*)(ws + WS_MG);
  const int tid = tid512(), lane = tid & 63, wave = tid >> 6;
  const int wm = wave >> 2, wn = wave & 3, lr = lane & 31, hh = lane >> 5;
  for (int kk = 0;; ++kk) {
    int mt, nt;
    if (!xcd_tile(kk, 8, 8, mt, nt)) break;
    const int m0 = mt * 256, n0 = nt * 256;
    f32x16 acc[4][2];
    zero_acc<4>(acc);
    gemm512<4>(acc, [&](int r) { return WT + (size_t)(n0 + r) * 1024; }, 64, [&](int r) { return XN2 + (size_t)(m0 + r) * 1024; }, 64, 16, smem);
#pragma unroll
    for (int i = 0; i < 4; ++i)
#pragma unroll
      for (int j = 0; j < 2; ++j)
#pragma unroll
        for (int q4 = 0; q4 < 4; ++q4) {
          const int f = n0 + wm * 128 + i * 32 + q4 * 8 + hh * 4;
          const size_t t = m0 + wn * 64 + j * 32 + lr;
          uint2 o;
          o.x = pack2(acc[i][j][q4 * 4 + 0], acc[i][j][q4 * 4 + 1]);
          o.y = pack2(acc[i][j][q4 * 4 + 2], acc[i][j][q4 * 4 + 3]);
          *(uint2*)(PQ + t * 2048 + f) = o;
        }
  }
}

template <int LOGN>
DI void bitonic_sort_desc(unsigned (&a)[1 << LOGN]) {
  constexpr int N = 1 << LOGN;
#pragma unroll
  for (int ks = 1; ks <= LOGN; ++ks)
#pragma unroll
    for (int js = ks - 1; js >= 0; --js)
#pragma unroll
      for (int i = 0; i < N; ++i) {
        const int k = 1 << ks, j = 1 << js, l = i ^ j;
        if (l > i) {
          const bool desc = ((i & k) == 0) || (ks == LOGN);
          const unsigned x = a[i], y = a[l];
          const unsigned hi = max(x, y), lo = min(x, y);
          a[i] = desc ? hi : lo;
          a[l] = desc ? lo : hi;
        }
      }
}
DI void merge_top16(unsigned (&a)[16], const unsigned (&b)[16]) {
#pragma unroll
  for (int i = 0; i < 16; ++i) a[i] = max(a[i], b[15 - i]);
#pragma unroll
  for (int js = 3; js >= 0; --js)
#pragma unroll
    for (int i = 0; i < 16; ++i) {
      const int j = 1 << js, l = i ^ j;
      if (l > i) {
        const unsigned x = a[i], y = a[l];
        a[i] = max(x, y);
        a[l] = min(x, y);
      }
    }
}

DI void peer_top16(const u16* __restrict__ PQrow, const u16* __restrict__ SK, unsigned (&top)[16], int lr, int hh) {
  bf16x8 qf[8];
#pragma unroll
  for (int ks = 0; ks < 8; ++ks) qf[ks] = *(const bf16x8*)(PQrow + ks * 16 + hh * 8);
  unsigned g[4][16];
#pragma unroll
  for (int kt = 0; kt < 4; ++kt) {
    f32x16 acc;
#pragma unroll
    for (int e = 0; e < 16; ++e) acc[e] = 0.f;
#pragma unroll
    for (int ks = 0; ks < 8; ++ks) {
      bf16x8 a = *(const bf16x8*)(SK + (size_t)(kt * 32 + lr) * 128 + ks * 16 + hh * 8);
      acc = MFMA32(a, qf[ks], acc);
    }
#pragma unroll
    for (int e = 0; e < 16; ++e) {
      int kidx = kt * 32 + crow(e, hh);
      g[kt][e] = (f2ord(acc[e]) & ~127u) | (unsigned)(127 - kidx);
    }
    bitonic_sort_desc<4>(g[kt]);
  }
  merge_top16(g[0], g[1]);
  merge_top16(g[2], g[3]);
  merge_top16(g[0], g[2]);
  unsigned other[16];
#pragma unroll
  for (int i = 0; i < 16; ++i) other[i] = (unsigned)__shfl_xor((int)g[0][i], 32);
  merge_top16(g[0], other);
#pragma unroll
  for (int i = 0; i < 16; ++i) top[i] = g[0][i];
}

template <bool STORE>
DI void peer_item(const Params& p, int item, char* smem) {
  char* ws = p.ws;
  const u16* PQ = (const u16*)(ws + WS_MG);
  const u16* SUBK = (const u16*)(ws + WS_SUBK);
  const u16* XN2 = (const u16*)(ws + WS_Q);
  int* e_s = (int*)smem;
  float* g_s = (float*)(e_s + 32 * 128);
  const int tid = my_tid(), lane = tid & 63, wave = tid >> 6;
  const int lr = lane & 31, hh = lane >> 5;
  const int tok0 = item * 32;
  hsync();
  for (int hq = 0; hq < 2; ++hq) {
    const int hd = wave * 2 + hq;
    unsigned top1[16], top2[16];
    const u16* pqrow = PQ + (size_t)(tok0 + lr) * 2048 + hd * 256;
    peer_top16(pqrow, SUBK + (size_t)(hd * 2 + 0) * 128 * 128, top1, lr, hh);
    peer_top16(pqrow + 128, SUBK + (size_t)(hd * 2 + 1) * 128 * 128, top2, lr, hh);
    unsigned ckey[16][16];
#pragma unroll
    for (int a = 0; a < 16; ++a)
#pragma unroll
      for (int bq = 0; bq < 16; ++bq)
        if ((a + 1) * (bq + 1) <= 16)
          ckey[a][bq] = (f2ord(ord2f(top1[a] & ~127u) + ord2f(top2[bq] & ~127u)) & ~255u) | (unsigned)(255 - (a * 16 + bq));
    unsigned wkey[16];
    int we[16];
#pragma unroll
    for (int r = 0; r < 16; ++r) {
      unsigned mx = 0u;
#pragma unroll
      for (int a = 0; a < 16; ++a)
#pragma unroll
        for (int bq = 0; bq < 16; ++bq)
          if ((a + 1) * (bq + 1) <= 16) mx = max(mx, ckey[a][bq]);
#pragma unroll
      for (int a = 0; a < 16; ++a)
#pragma unroll
        for (int bq = 0; bq < 16; ++bq)
          if ((a + 1) * (bq + 1) <= 16) ckey[a][bq] = (ckey[a][bq] == mx) ? 0u : ckey[a][bq];
      wkey[r] = mx;
      const int cidx = 255 - (int)(mx & 255u);
      const int wa = cidx >> 4, wb = cidx & 15;
      unsigned t1 = top1[0], t2 = top2[0];
#pragma unroll
      for (int a = 1; a < 16; ++a) { t1 = (wa == a) ? top1[a] : t1; t2 = (wb == a) ? top2[a] : t2; }
      we[r] = (127 - (int)(t1 & 127u)) * 128 + (127 - (int)(t2 & 127u));
    }
    float cs0 = ord2f(wkey[0] & ~255u);
    float ex[16], sum = 0.f;
#pragma unroll
    for (int r = 0; r < 16; ++r) { ex[r] = __expf(ord2f(wkey[r] & ~255u) - cs0); sum += ex[r]; }
    float inv = 1.f / sum;
    if (hh == 0) {
#pragma unroll
      for (int r = 0; r < 16; ++r) {
        e_s[lr * 128 + hd * 16 + r] = we[r];
        g_s[lr * 128 + hd * 16 + r] = ex[r] * inv;
      }
    }
  }
  hsync();
  const unsigned char* U8 = (const unsigned char*)(ws + WS_UBF);
  const float* SU = (const float*)(ws + WS_SU);
  const float* SV = (const float*)(ws + WS_SV);
  int* EG = (int*)(ws + WS_XN);
  float* AG = (float*)(ws + WS_XN + (size_t)T_TOK * 128 * 4);
  const bool b5 = (lane & 32) != 0, b4 = (lane & 16) != 0, b3 = (lane & 8) != 0;
#pragma unroll 1
  for (int ti = 0; ti < 8; ++ti) {
    const int tl = wave * 8 + ti;
    const size_t tok = (size_t)tok0 + tl;
    float xf[16];
    {
#pragma unroll
      for (int i = 0; i < 4; ++i) {
        const uint2 xv = *(const uint2*)(XN2 + tok * 1024 + 256 * i + lane * 4);
        xf[4 * i] = bflo(xv.x); xf[4 * i + 1] = bfhi(xv.x); xf[4 * i + 2] = bflo(xv.y); xf[4 * i + 3] = bfhi(xv.y);
      }
    }
#pragma unroll 2
    for (int k = 0; k < 128; k += 8) {
      u32x4 uq[8];
      const int emine = e_s[tl * 128 + k + (lane >> 3)];
      const float gmine = g_s[tl * 128 + k + (lane >> 3)];
      const float su = SU[emine], sv = SV[emine];
#pragma unroll
      for (int u = 0; u < 8; ++u) {
        int e = e_s[tl * 128 + k + u];
        uq[u] = *(const u32x4*)(U8 + (size_t)e * 1024 + lane * 16);
      }
      float part[8];
#pragma unroll
      for (int u = 0; u < 8; ++u) {
        float d = 0.f;
#pragma unroll
        for (int i = 0; i < 4; ++i) {
          f32x2_t lo = __builtin_amdgcn_cvt_pk_f32_fp8((int)uq[u][i], false);
          f32x2_t hi = __builtin_amdgcn_cvt_pk_f32_fp8((int)uq[u][i], true);
          d += xf[4 * i] * lo.x + xf[4 * i + 1] * lo.y + xf[4 * i + 2] * hi.x + xf[4 * i + 3] * hi.y;
        }
        part[u] = d;
      }
      float q4[4], r2[2], h;
#pragma unroll
      for (int j = 0; j < 4; ++j) {
        float mine = b5 ? part[j + 4] : part[j];
        float other = b5 ? part[j] : part[j + 4];
        q4[j] = mine + __shfl_xor(other, 32);
      }
#pragma unroll
      for (int j = 0; j < 2; ++j) {
        float mine = b4 ? q4[j + 2] : q4[j];
        float other = b4 ? q4[j] : q4[j + 2];
        r2[j] = mine + __shfl_xor(other, 16);
      }
      {
        float mine = b3 ? r2[1] : r2[0];
        float other = b3 ? r2[0] : r2[1];
        h = mine + __shfl_xor(other, 8);
      }
      h += __shfl_xor(h, 4);
      h += __shfl_xor(h, 2);
      h += __shfl_xor(h, 1);
      const float amine = gelu_exact(h * su) * gmine * sv;
      if ((lane & 7) == 0) {
        EG[tok * 128 + k + (lane >> 3)] = emine;
        AG[tok * 128 + k + (lane >> 3)] = amine;
      }
    }
  }
  hsync();
}

DI void peer_item_v(const Params& p, int item) {
  char* ws = p.ws;
  const unsigned char* V8 = (const unsigned char*)(ws + WS_VBF);
  const int* EG = (const int*)(ws + WS_XN);
  const float* AG = (const float*)(ws + WS_XN + (size_t)T_TOK * 128 * 4);
  const int tid = my_tid(), lane = tid & 63, wave = tid >> 6;
#pragma unroll 1
  for (int ti = 0; ti < 8; ++ti) {
    const size_t tok = (size_t)item * 32 + wave * 8 + ti;
    const int e_lo = EG[tok * 128 + lane], e_hi = EG[tok * 128 + 64 + lane];
    const int a_lo = __float_as_int(AG[tok * 128 + lane]), a_hi = __float_as_int(AG[tok * 128 + 64 + lane]);
    float out[16];
#pragma unroll
    for (int i = 0; i < 16; ++i) out[i] = 0.f;
    u32x4 vqa[8], vqb[8];
#define V_ISSUE(VQ, G)                                                                              \
    {                                                                                                \
      const int g_ = (G);                                                                            \
      _Pragma("unroll") for (int u = 0; u < 8; ++u) {                                                \
        const int e = (g_ < 8) ? __builtin_amdgcn_readlane(e_lo, (g_ & 7) * 8 + u)                   \
                               : __builtin_amdgcn_readlane(e_hi, (g_ & 7) * 8 + u);                  \
        (VQ)[u] = *(const u32x4*)(V8 + (size_t)e * 1024 + lane * 16);                                \
      }                                                                                              \
      __builtin_amdgcn_sched_barrier(0);                                                             \
    }
#define V_CONSUME(VQ, G)                                                                            \
    {                                                                                                \
      const int g_ = (G);                                                                            \
      _Pragma("unroll") for (int u = 0; u < 8; ++u) {                                                \
        const float a = __int_as_float((g_ < 8) ? __builtin_amdgcn_readlane(a_lo, (g_ & 7) * 8 + u)  \
                                                : __builtin_amdgcn_readlane(a_hi, (g_ & 7) * 8 + u)); \
        _Pragma("unroll") for (int i = 0; i < 4; ++i) {                                              \
          f32x2_t lo = __builtin_amdgcn_cvt_pk_f32_fp8((int)(VQ)[u][i], false);                      \
          f32x2_t hi = __builtin_amdgcn_cvt_pk_f32_fp8((int)(VQ)[u][i], true);                       \
          out[4 * i] += a * lo.x; out[4 * i + 1] += a * lo.y; out[4 * i + 2] += a * hi.x; out[4 * i + 3] += a * hi.y; \
        }                                                                                            \
      }                                                                                              \
    }
    V_ISSUE(vqa, 0)
#pragma unroll 1
    for (int g = 0; g < 16; g += 2) {
      V_ISSUE(vqb, g + 1)
      V_CONSUME(vqa, g)
      if (g + 2 < 16) V_ISSUE(vqa, g + 2)
      V_CONSUME(vqb, g + 1)
    }
#undef V_ISSUE
#undef V_CONSUME
    float* orow = p.out + tok * 1024 + lane * 4;
    float4 y[4];
    float ss = 0.f;
#pragma unroll
    for (int i = 0; i < 4; ++i) {
      y[i] = *(const float4*)(orow + 256 * i);
      y[i].x += out[4 * i]; y[i].y += out[4 * i + 1]; y[i].z += out[4 * i + 2]; y[i].w += out[4 * i + 3];
      ss += y[i].x * y[i].x + y[i].y * y[i].y + y[i].z * y[i].z + y[i].w * y[i].w;
    }
    ss = wave_sum(ss);
    const float r = rsqrtf(ss * (1.f / 1024.f) + 1e-6f);
#pragma unroll
    for (int i = 0; i < 4; ++i) {
      float4 g = *(const float4*)(p.g_final + 256 * i + lane * 4);
      y[i].x *= r * g.x; y[i].y *= r * g.y; y[i].z *= r * g.z; y[i].w *= r * g.w;
      *(float4*)(orow + 256 * i) = y[i];
    }
  }
}

template <bool STORE>
DI void phase_peer(const Params& p, char* smem) {
  for (int it = vb_id(); it < 512; it += vb_n()) peer_item<STORE>(p, it, smem);
}
DI void phase_peer_v(const Params& p) {
  for (int it = vb_id(); it < 512; it += vb_n()) peer_item_v(p, it);
}

__global__ void __launch_bounds__(512) fwd_megakernel(Params p) {
  extern __shared__ __attribute__((aligned(16))) char smem[];
  cg::grid_group grid = cg::this_grid();
  __shared__ uint4 xb_words;
  if (threadIdx.x == 0) {
    xb_words = make_uint4(0u, 0u, 0u, 0u);
    hsync_impl(true);
  }
  __syncthreads();
  if (p.ws == nullptr) grid.sync();
  XcdBarrier xb = xcd_barrier_post((unsigned*)(p.ws + WS_BAR), (volatile LAS unsigned*)&xb_words);
  char* hsm = smem + half_id() * HALF_LDS;
  phase_prep(p, hsm, 0, vb_id());
  xcd_barrier(xb);
  phase_inproj(p, smem);
  xcd_barrier(xb);
  phase_compress(p, hsm);
  phase_prep(p, hsm, 1, (vb_id() + vb_n() - 128) % vb_n());
  xcd_barrier(xb);
  phase_mix(p, hsm);
  xcd_barrier(xb);
  phase_merge(p, smem);
  xcd_barrier(xb);
  phase_wo(p, smem);
  xcd_barrier(xb);
  phase_norm2(p);
  xcd_barrier(xb);
  phase_pq(p, smem);
  xcd_barrier(xb);
  phase_peer<true>(p, hsm);
  xcd_barrier(xb);
  phase_peer_v(p);
}

extern "C" void kernel_launch(void* const* d_in, const int* in_sizes, int n_in, void* d_out, int out_size, void* d_ws,
                              size_t ws_size, hipStream_t stream) {
  static int grid_blocks = 0;
  if (!grid_blocks) {
    int dev = 0, cus = 0, per_cu = 0;
    hipGetDevice(&dev);
    hipDeviceGetAttribute(&cus, hipDeviceAttributeMultiprocessorCount, dev);
    hipFuncSetAttribute((const void*)fwd_megakernel, hipFuncAttributeMaxDynamicSharedMemorySize, DYN_LDS);
    hipOccupancyMaxActiveBlocksPerMultiprocessor(&per_cu, fwd_megakernel, 512, DYN_LDS);
    if (per_cu > 1) per_cu = 1;
    if (per_cu < 1) per_cu = 1;
    grid_blocks = cus * per_cu;
  }
  Params p{};
  const float** pf = (const float**)&p;
  for (int i = 0; i < 22; ++i) pf[i] = (const float*)d_in[i];
  p.out = (float*)d_out;
  p.ws = (char*)d_ws;
  hipMemsetAsync((char*)d_ws + WS_BAR, 0, 3456 * 4, stream);
  void* args[] = {&p};
  hipError_t e = hipLaunchCooperativeKernel((void*)fwd_megakernel, dim3(grid_blocks), dim3(512), args, DYN_LDS, stream);
  if (e != hipSuccess) fprintf(stderr, "cooperative launch failed: %s (grid %d)\n", hipGetErrorString(e), grid_blocks);
}
```

```cpp
#include <hip/hip_runtime.h>
#include <hip/hip_cooperative_groups.h>
#include <cstdio>
namespace cg = cooperative_groups;

typedef unsigned short u16;
typedef unsigned long long u64;
typedef short bf16x8 __attribute__((ext_vector_type(8)));
typedef short s16x4 __attribute__((ext_vector_type(4)));
typedef float f32x16 __attribute__((ext_vector_type(16)));
typedef float f32x2_t __attribute__((ext_vector_type(2)));
typedef unsigned u32x4 __attribute__((ext_vector_type(4)));
typedef __bf16 bf16x2_t __attribute__((ext_vector_type(2)));

#define DI __device__ __forceinline__
#define MFMA32(a, b, c) __builtin_amdgcn_mfma_f32_32x32x16_bf16((a), (b), (c), 0, 0, 0)

constexpr int T_TOK = 16384;
constexpr int SEQ = 4096;
constexpr int NIN = 4608;
constexpr int HALF_LDS = 81664;
constexpr int DYN_LDS = 2 * HALF_LDS;
constexpr float LOG2E = 1.4426950408889634f;

constexpr size_t al256(size_t x) { return (x + 255) / 256 * 256; }
constexpr size_t WS_WT_IN   = 0;
constexpr size_t WS_WT_NSA  = al256(WS_WT_IN + (size_t)NIN * 1024 * 2);
constexpr size_t WS_WT_CONV = al256(WS_WT_NSA + 1024ull * 512 * 2);
constexpr size_t WS_WT_O    = al256(WS_WT_CONV + 1024ull * 512 * 2);
constexpr size_t WS_WT_PQ   = al256(WS_WT_O + 1024ull * 1024 * 2);
constexpr size_t WS_WT_C1   = al256(WS_WT_PQ + 2048ull * 1024 * 2);
constexpr size_t WS_SUBK    = al256(WS_WT_C1 + 128ull * 2048 * 2);
constexpr size_t WS_BIAS    = al256(WS_SUBK + 262144ull * 2);
constexpr size_t WS_UBF     = al256(WS_BIAS + 128 * 4);
constexpr size_t WS_VBF     = al256(WS_UBF + 16384ull * 1024 * 2);
constexpr size_t WS_XN      = al256(WS_VBF + 16384ull * 1024 * 2);
constexpr size_t WS_Q       = al256(WS_XN + 16384ull * 1024 * 2);
constexpr size_t WS_KC      = al256(WS_Q + 16384ull * 512 * 2);
constexpr size_t WS_VC      = al256(WS_KC + 16384ull * 128 * 2);
constexpr size_t WS_KS      = al256(WS_VC + 16384ull * 128 * 2);
constexpr size_t WS_KW      = al256(WS_KS + 16384ull * 128 * 2);
constexpr size_t WS_VTS     = al256(WS_KW + 16384ull * 128 * 2);
constexpr size_t WS_VTW     = al256(WS_VTS + 16384ull * 128 * 2);
constexpr size_t WS_KCMP    = al256(WS_VTW + 16384ull * 128 * 2);
constexpr size_t WS_VCMPT   = al256(WS_KCMP + 8ull * 256 * 64 * 2);
constexpr size_t WS_NG      = al256(WS_VCMPT + 8ull * 256 * 64 * 2);
constexpr size_t WS_GLU     = al256(WS_NG + 16384ull * 32 * 4);
constexpr size_t WS_MG      = al256(WS_GLU + 16384ull * 512 * 2);
constexpr size_t WS_END     = al256(WS_MG + 16384ull * 2048 * 2);
constexpr size_t WS_SU = WS_UBF + 16384ull * 1024;
constexpr size_t WS_SV = WS_VBF + 16384ull * 1024;
constexpr size_t WS_BAR = WS_END;
constexpr size_t WS_END2 = al256(WS_BAR + 3456 * 4);
static_assert(WS_END2 <= 256ull * 1024 * 1024, "workspace too big");
static_assert(WS_VTS - WS_Q == 16384ull * 1024 * 2, "xn2 alias region");

struct Params {
  const float *x, *g_mix, *w_in, *pe_k, *pe_v, *w_k1, *w_k2, *w_v1, *w_v2, *w_nsa_out, *w_dw, *b_dw, *g_ln, *b_ln,
      *w_conv_out, *w_o, *g_ffn, *w_pq, *subk, *pu, *pv, *g_final;
  float* out;
  char* ws;
};

DI u16 f2bf(float x) {
  unsigned u = __float_as_uint(x);
  u += 0x7fffu + ((u >> 16) & 1u);
  return (u16)(u >> 16);
}
DI unsigned pack2(float a, float b) {
  f32x2_t v = {a, b};
  bf16x2_t r = __builtin_convertvector(v, bf16x2_t);
  return __builtin_bit_cast(unsigned, r);
}
DI int my_tid() { int t = threadIdx.x & 255; asm volatile("" : "+v"(t)); return t; }
DI int tid512() { int t = threadIdx.x; asm volatile("" : "+v"(t)); return t; }
DI int half_id() { return __builtin_amdgcn_readfirstlane((int)(threadIdx.x >> 8)); }
DI int vb_id() { return (int)blockIdx.x + half_id() * (int)gridDim.x; }
DI int vb_n() { return (int)gridDim.x * 2; }
DI void hsync_impl(const bool INIT) {
  __shared__ unsigned hb[4];
  if (INIT) {
    hb[0] = 0u; hb[1] = 0u; hb[2] = 0u; hb[3] = 0u;
    return;
  }
  asm volatile("s_waitcnt vmcnt(0) lgkmcnt(0)" ::: "memory");
  if ((threadIdx.x & 63) == 0) {
    const int h2 = 2 * half_id();
    const unsigned gen = __hip_atomic_load(&hb[h2 + 1], __ATOMIC_RELAXED, __HIP_MEMORY_SCOPE_WORKGROUP);
    const unsigned old = __hip_atomic_fetch_add(&hb[h2], 1u, __ATOMIC_RELAXED, __HIP_MEMORY_SCOPE_WORKGROUP);
    if (old == 3u) {
      __hip_atomic_store(&hb[h2], 0u, __ATOMIC_RELAXED, __HIP_MEMORY_SCOPE_WORKGROUP);
      asm volatile("s_waitcnt vmcnt(0) lgkmcnt(0)" ::: "memory");
      __hip_atomic_fetch_add(&hb[h2 + 1], 1u, __ATOMIC_RELAXED, __HIP_MEMORY_SCOPE_WORKGROUP);
    } else {
      while (__hip_atomic_load(&hb[h2 + 1], __ATOMIC_RELAXED, __HIP_MEMORY_SCOPE_WORKGROUP) == gen) __builtin_amdgcn_s_sleep(1);
    }
  }
  asm volatile("s_waitcnt vmcnt(0) lgkmcnt(0)" ::: "memory");
}
DI void hsync() { hsync_impl(false); }
DI float bflo(unsigned u) { return __uint_as_float(u << 16); }
DI float bfhi(unsigned u) { return __uint_as_float(u & 0xffff0000u); }
DI float wave_sum(float v) {
#pragma unroll
  for (int o = 32; o > 0; o >>= 1) v += __shfl_xor(v, o);
  return v;
}
template <int CTRL>
DI float dpp_f(float x) { return __int_as_float(__builtin_amdgcn_update_dpp(0, __float_as_int(x), CTRL, 0xF, 0xF, true)); }
DI float sigmoidf_(float x) { return 1.f / (1.f + __expf(-x)); }
DI float gelu_exact(float x) { return 0.5f * x * (1.f + erff(x * 0.7071067811865476f)); }
DI float fexp2(float x) { return __builtin_amdgcn_exp2f(x); }
DI int swap23(int t) { return (t & ~12) | ((t & 4) << 1) | ((t & 8) >> 1); }
DI int crow(int i, int hh) { return (i & 3) + 8 * (i >> 2) + 4 * hh; }
DI unsigned f2ord(float f) {
  unsigned u = __float_as_uint(f);
  return (u & 0x80000000u) ? ~u : (u | 0x80000000u);
}
DI float ord2f(unsigned u) { return __uint_as_float((u & 0x80000000u) ? (u ^ 0x80000000u) : ~u); }

#define XB_TMO      128
#define XB_XCNT(j)  (256  + 64 * (j))
#define XB_XSUB(j)  (1280 + 64 * (j))
#define XB_XGEN(j)  (2304 + 64 * (j))
#define XB_TOP      3328
#define XB_TOPGEN   3392
#define XCD_BAR_WORDS 3456
#define XB_SPIN_CAP (1u << 18)
#define LAS __attribute__((address_space(3)))

__device__ __forceinline__ unsigned xb_ld(unsigned* p)              { return __hip_atomic_load(p, __ATOMIC_RELAXED, __HIP_MEMORY_SCOPE_AGENT); }
__device__ __forceinline__ unsigned xb_add(unsigned* p, unsigned v) { return __hip_atomic_fetch_add(p, v, __ATOMIC_RELAXED, __HIP_MEMORY_SCOPE_AGENT); }
__device__ __forceinline__ unsigned xb_xcc_id() { return (unsigned)__builtin_amdgcn_s_getreg((3 << 11) | 20) & 0xFu; }
#define XB_SPIN(cond, bar) do { unsigned _sp = 0; while (cond) { __builtin_amdgcn_s_sleep(1); \
    if ((++_sp & 255u) == 0u) { if (xb_ld(&(bar)[XB_TMO])) break; if (_sp > XB_SPIN_CAP) { atomicAdd(&(bar)[XB_TMO], 1u); break; } } } } while (0)

struct XcdBarrier {
    unsigned* bar; unsigned x;
    volatile LAS unsigned* st;
};

__device__ __forceinline__ XcdBarrier xcd_barrier_post(unsigned* bar, volatile LAS unsigned* st) {
    XcdBarrier b; b.bar = bar; b.x = xb_xcc_id(); b.st = st;
    if (threadIdx.x == 0) (void)xb_add(&bar[XB_XCNT(b.x)], 1u);
    return b;
}
__device__ __forceinline__ void xcd_barrier_complete(unsigned* bar, unsigned x, unsigned& nloc, unsigned& nx) {
    const unsigned G = gridDim.x * gridDim.y * gridDim.z;
    unsigned sum, cnt, mine, sp = 0u;
    for (;;) {
        sum = 0u; cnt = 0u; mine = 0u;
#pragma unroll
        for (unsigned j = 0; j < 16; ++j) { const unsigned c = xb_ld(&bar[XB_XCNT(j)]); sum += c; cnt += (c > 0u) ? 1u : 0u; mine = (j == x) ? c : mine; }
        if (sum == G) break;
        __builtin_amdgcn_s_sleep(1);
        if ((++sp & 255u) == 0u) { if (xb_ld(&bar[XB_TMO])) break; if (sp > XB_SPIN_CAP) { atomicAdd(&bar[XB_TMO], 1u); break; } }
    }
    nloc = mine > 0u ? mine : 1u; nx = cnt > 0u ? cnt : 1u;
}

__device__ __forceinline__ void xcd_barrier(const XcdBarrier& b) {
    asm volatile("s_waitcnt vmcnt(0)" ::: "memory");
    __syncthreads();
    if (threadIdx.x == 0) {
        unsigned* bar = b.bar;
        __builtin_amdgcn_s_waitcnt(0);
        unsigned nloc = b.st[0], nx = b.st[1];
        if (nloc == 0u) { xcd_barrier_complete(bar, b.x, nloc, nx); b.st[0] = nloc; b.st[1] = nx; }
        const unsigned old = xb_add(&bar[XB_XSUB(b.x)], 1u);
        const unsigned gen = old / nloc;
        if (old + 1u == (gen + 1u) * nloc) {
            __builtin_amdgcn_fence(__ATOMIC_RELEASE, "agent");
            asm volatile("s_waitcnt vmcnt(0)" ::: "memory");
            const unsigned og = xb_add(&bar[XB_TOP], 1u);
            const unsigned tg = og / nx;
            if (og + 1u == (tg + 1u) * nx) xb_add(&bar[XB_TOPGEN], 1u);
            else XB_SPIN(xb_ld(&bar[XB_TOPGEN]) == tg, bar);
            __builtin_amdgcn_fence(__ATOMIC_ACQUIRE, "agent");
            xb_add(&bar[XB_XGEN(b.x)], 1u);
            asm volatile("s_waitcnt vmcnt(0)" ::: "memory");
        } else {
            XB_SPIN(xb_ld(&bar[XB_XGEN(b.x)]) == gen, bar);
            __builtin_amdgcn_fence(__ATOMIC_ACQUIRE, "agent");
            asm volatile("s_waitcnt vmcnt(0)" ::: "memory");
        }
    }
    __syncthreads();
}


DI int inproj_colmap(int p) {
  if (p < 1280) return p;
  if (p < 2304) {
    int j = p - 1280;
    int blk = j >> 7, w = j & 127;
    return 1304 + (w < 64 ? blk * 64 + w : 512 + blk * 64 + (w - 64));
  }
  if (p < 4352) return 2328 + (p - 2304);
  if (p < 4376) return 1280 + (p - 4352);
  return -1;
}

template <bool MAPPED>
DI void transpose_tile(const float* __restrict__ W, int K, int N, u16* __restrict__ Wt, int kt, int nt, char* smem) {
  float* s = (float*)smem;
  const int tid = my_tid();
  hsync();
#pragma unroll 4
  for (int i = 0; i < 16; ++i) {
    int idx = tid + 256 * i;
    int kk = idx >> 6, pp = idx & 63;
    int pcol = nt * 64 + pp;
    int oc = MAPPED ? inproj_colmap(pcol) : pcol;
    float v = 0.f;
    if (oc >= 0) v = W[(size_t)(kt * 64 + kk) * N + oc];
    s[kk * 65 + pp] = v;
  }
  hsync();
#pragma unroll 4
  for (int i = 0; i < 16; ++i) {
    int idx = tid + 256 * i;
    int pp = idx >> 6, kk = idx & 63;
    Wt[(size_t)(nt * 64 + pp) * K + kt * 64 + kk] = f2bf(s[kk * 65 + pp]);
  }
}

DI void rms_row(const float* __restrict__ xr, const float* __restrict__ g, u16* __restrict__ dst, int lane) {
  float4 v[4];
  float ss = 0.f;
#pragma unroll
  for (int i = 0; i < 4; ++i) {
    v[i] = *(const float4*)(xr + lane * 4 + 256 * i);
    ss += v[i].x * v[i].x + v[i].y * v[i].y + v[i].z * v[i].z + v[i].w * v[i].w;
  }
  ss = wave_sum(ss);
  float r = rsqrtf(ss * (1.f / 1024.f) + 1e-6f);
#pragma unroll
  for (int i = 0; i < 4; ++i) {
    float4 gg = *(const float4*)(g + lane * 4 + 256 * i);
    uint2 o;
    o.x = pack2(v[i].x * r * gg.x, v[i].y * r * gg.y);
    o.y = pack2(v[i].z * r * gg.z, v[i].w * r * gg.w);
    *(uint2*)(dst + lane * 4 + 256 * i) = o;
  }
}

DI void convert_chunk(const float* __restrict__ src, u16* __restrict__ dst, int item) {
  const int tid = my_tid();
#pragma unroll
  for (int i = 0; i < 4; ++i) {
    size_t idx = (size_t)item * 8192 + i * 2048 + tid * 8;
    float4 a = *(const float4*)(src + idx);
    float4 b = *(const float4*)(src + idx + 4);
    uint4 o;
    o.x = pack2(a.x, a.y); o.y = pack2(a.z, a.w); o.z = pack2(b.x, b.y); o.w = pack2(b.z, b.w);
    *(uint4*)(dst + idx) = o;
  }
}

template <int NR>
DI void fp8_rows(const float* __restrict__ src, unsigned char* __restrict__ dst, float* __restrict__ scale_out, int lane) {
  float4 v[NR][4];
#pragma unroll
  for (int r = 0; r < NR; ++r)
#pragma unroll
    for (int i = 0; i < 4; ++i) v[r][i] = *(const float4*)(src + (size_t)r * 1024 + 256 * i + lane * 4);
#pragma unroll
  for (int r = 0; r < NR; ++r) {
    float amax = 0.f;
#pragma unroll
    for (int i = 0; i < 4; ++i)
      amax = fmaxf(amax, fmaxf(fmaxf(fabsf(v[r][i].x), fabsf(v[r][i].y)), fmaxf(fabsf(v[r][i].z), fabsf(v[r][i].w))));
#pragma unroll
    for (int o = 32; o > 0; o >>= 1) amax = fmaxf(amax, __shfl_xor(amax, o));
    const float scale = amax > 0.f ? amax * (1.f / 440.f) : 1.f;
    const float inv = 1.f / scale;
    u32x4 w;
#pragma unroll
    for (int i = 0; i < 4; ++i) {
      int t = 0;
      t = __builtin_amdgcn_cvt_pk_fp8_f32(v[r][i].x * inv, v[r][i].y * inv, t, false);
      t = __builtin_amdgcn_cvt_pk_fp8_f32(v[r][i].z * inv, v[r][i].w * inv, t, true);
      w[i] = (unsigned)t;
    }
    *(u32x4*)(dst + (size_t)r * 1024 + lane * 16) = w;
    if (lane == 0) scale_out[r] = scale;
  }
}

template <int NR>
DI void rms_rows(const float* __restrict__ xr, const float* __restrict__ g, u16* __restrict__ dst, int lane) {
  float4 v[NR][4];
#pragma unroll
  for (int r = 0; r < NR; ++r)
#pragma unroll
    for (int i = 0; i < 4; ++i) v[r][i] = *(const float4*)(xr + (size_t)r * 1024 + lane * 4 + 256 * i);
  float4 gg[4];
#pragma unroll
  for (int i = 0; i < 4; ++i) gg[i] = *(const float4*)(g + lane * 4 + 256 * i);
#pragma unroll
  for (int r = 0; r < NR; ++r) {
    float ss = 0.f;
#pragma unroll
    for (int i = 0; i < 4; ++i) ss += v[r][i].x * v[r][i].x + v[r][i].y * v[r][i].y + v[r][i].z * v[r][i].z + v[r][i].w * v[r][i].w;
    ss = wave_sum(ss);
    const float rr = rsqrtf(ss * (1.f / 1024.f) + 1e-6f);
#pragma unroll
    for (int i = 0; i < 4; ++i) {
      uint2 o;
      o.x = pack2(v[r][i].x * rr * gg[i].x, v[r][i].y * rr * gg[i].y);
      o.y = pack2(v[r][i].z * rr * gg[i].z, v[r][i].w * rr * gg[i].w);
      *(uint2*)(dst + (size_t)r * 1024 + lane * 4 + 256 * i) = o;
    }
  }
}

DI void phase_prep(const Params& p, char* smem, int part, int vb) {
  char* ws = p.ws;
  const int tid = my_tid(), lane = tid & 63, wave = tid >> 6;
  if (part == 0) {
    const int NITEMS = 1024 + 1152 + 64;
    for (int it0 = vb; it0 < NITEMS; it0 += vb_n()) {
      int it = it0;
      if (it < 1024) {
        int row = it * 16 + wave * 4;
        rms_rows<4>(p.x + (size_t)row * 1024, p.g_mix, (u16*)(ws + WS_XN) + (size_t)row * 1024, lane);
        continue;
      }
      it -= 1024;
      if (it < 1152) { transpose_tile<true>(p.w_in, 1024, 4376, (u16*)(ws + WS_WT_IN), it / 72, it % 72, smem); continue; }
      it -= 1152;
      {
        int kv = it >> 5, kt = it & 31;
        transpose_tile<false>(kv ? p.w_v1 : p.w_k1, 2048, 64, (u16*)(ws + WS_WT_C1) + (size_t)kv * 64 * 2048, kt, 0, smem);
      }
    }
  } else {
    const int NITEMS = 1024 + 1024 + 128 + 128 + 256 + 512 + 32;
    for (int it0 = vb; it0 < NITEMS; it0 += vb_n()) {
      int it = it0;
      if (it < 1024) {
        int row = it * 16 + wave * 4;
        fp8_rows<4>(p.pu + (size_t)row * 1024, (unsigned char*)(ws + WS_UBF) + (size_t)row * 1024, (float*)(ws + WS_SU) + row, lane);
        continue;
      }
      it -= 1024;
      if (it < 1024) {
        int row = it * 16 + wave * 4;
        fp8_rows<4>(p.pv + (size_t)row * 1024, (unsigned char*)(ws + WS_VBF) + (size_t)row * 1024, (float*)(ws + WS_SV) + row, lane);
        continue;
      }
      it -= 1024;
      if (it < 128) { transpose_tile<false>(p.w_nsa_out, 512, 1024, (u16*)(ws + WS_WT_NSA), it / 16, it % 16, smem); continue; }
      it -= 128;
      if (it < 128) { transpose_tile<false>(p.w_conv_out, 512, 1024, (u16*)(ws + WS_WT_CONV), it / 16, it % 16, smem); continue; }
      it -= 128;
      if (it < 256) { transpose_tile<false>(p.w_o, 1024, 1024, (u16*)(ws + WS_WT_O), it / 16, it % 16, smem); continue; }
      it -= 256;
      if (it < 512) { transpose_tile<false>(p.w_pq, 1024, 2048, (u16*)(ws + WS_WT_PQ), it / 32, it % 32, smem); continue; }
      it -= 512;
      convert_chunk(p.subk, (u16*)(ws + WS_SUBK), it);
    }
  }
}

template <int WM, class AF, class BF>
DI void gemm512(f32x16 (&acc)[WM][2], AF arow, int a_kstep, BF brow, int b_kstep, int KT, char* smem) {
  constexpr int AM = WM * 64;
  constexpr int NA = AM / 64;
  const int tid = tid512(), lane = tid & 63, wave = tid >> 6;
  const int wm = wave >> 2, wn = wave & 3, lr = lane & 31, hh = lane >> 5;
  const u16* ap[NA];
  const u16* bp[4];
  int soa[NA], sob[4];
#pragma unroll
  for (int i = 0; i < NA; ++i) {
    int c = tid + 512 * i;
    int row = c >> 3, kc = (c & 7) * 8;
    ap[i] = arow(row) + kc;
    soa[i] = row * 72 + kc;
  }
#pragma unroll
  for (int i = 0; i < 4; ++i) {
    int c = tid + 512 * i;
    int row = c >> 3, kc = (c & 7) * 8;
    bp[i] = brow(row) + kc;
    sob[i] = row * 72 + kc;
  }
  u32x4 ra0[NA], rb0[4], ra1[NA], rb1[4];
#pragma unroll
  for (int i = 0; i < NA; ++i) ra0[i] = *(const u32x4*)ap[i];
#pragma unroll
  for (int i = 0; i < 4; ++i) rb0[i] = *(const u32x4*)bp[i];
  {
    const int s1 = (KT > 1) ? 1 : 0;
#pragma unroll
    for (int i = 0; i < NA; ++i) ra1[i] = *(const u32x4*)(ap[i] + s1 * a_kstep);
#pragma unroll
    for (int i = 0; i < 4; ++i) rb1[i] = *(const u32x4*)(bp[i] + s1 * b_kstep);
  }
  u16* A0 = (u16*)smem;
  u16* B0 = A0 + AM * 72;
  u16* A1 = B0 + 256 * 72;
  u16* B1 = A1 + AM * 72;
  __syncthreads();
#pragma unroll
  for (int i = 0; i < NA; ++i) *(u32x4*)(A0 + soa[i]) = ra0[i];
#pragma unroll
  for (int i = 0; i < 4; ++i) *(u32x4*)(B0 + sob[i]) = rb0[i];
  __syncthreads();
  const int fa = (wm * WM * 32 + lr) * 72 + hh * 8, fb = (wn * 64 + lr) * 72 + hh * 8;
#define GEMM_STEP(AS, BS, AD, BD, RLA, RLB, RSA, RSB, SNEXT)                                      \
  {                                                                                              \
    const int sn = (SNEXT) < KT ? (SNEXT) : KT - 1;                                              \
    _Pragma("unroll") for (int i = 0; i < NA; ++i) RLA[i] = *(const u32x4*)(ap[i] + sn * a_kstep); \
    _Pragma("unroll") for (int i = 0; i < 4; ++i) RLB[i] = *(const u32x4*)(bp[i] + sn * b_kstep);  \
    _Pragma("unroll") for (int ks = 0; ks < 4; ++ks) {                                           \
      bf16x8 b0 = *(const bf16x8*)((BS) + fb + ks * 16);                                         \
      bf16x8 b1 = *(const bf16x8*)((BS) + fb + 32 * 72 + ks * 16);                               \
      _Pragma("unroll") for (int i = 0; i < WM; ++i) {                                           \
        bf16x8 a = *(const bf16x8*)((AS) + fa + i * 32 * 72 + ks * 16);                          \
        acc[i][0] = MFMA32(a, b0, acc[i][0]);                                                    \
        acc[i][1] = MFMA32(a, b1, acc[i][1]);                                                    \
      }                                                                                          \
    }                                                                                            \
    _Pragma("unroll") for (int i = 0; i < NA; ++i) *(u32x4*)((AD) + soa[i]) = RSA[i];            \
    _Pragma("unroll") for (int i = 0; i < 4; ++i) *(u32x4*)((BD) + sob[i]) = RSB[i];             \
    __syncthreads();                                                                             \
  }
#pragma unroll 1
  for (int kt = 0; kt < KT; kt += 2) {
    GEMM_STEP(A0, B0, A1, B1, ra0, rb0, ra1, rb1, kt + 2)
    if (kt + 1 < KT) GEMM_STEP(A1, B1, A0, B0, ra1, rb1, ra0, rb0, kt + 3)
  }
#undef GEMM_STEP
}

template <int WM>
DI void zero_acc(f32x16 (&acc)[WM][2]) {
#pragma unroll
  for (int i = 0; i < WM; ++i)
#pragma unroll
    for (int j = 0; j < 2; ++j)
#pragma unroll
      for (int e = 0; e < 16; ++e) acc[i][j][e] = 0.f;
}

DI bool xcd_tile(int k, int NT, int MPX, int& mt, int& nt) {
  const int x = blockIdx.x & 7, lb = blockIdx.x >> 3, nlb = gridDim.x >> 3;
  const int r = lb + nlb * k;
  if (r >= MPX * NT) return false;
  nt = r / MPX;
  mt = x * MPX + (r % MPX);
  return true;
}

template <int WM>
DI void inproj_tile(const Params& p, char* smem, const int m0, const int n0) {
  char* ws = p.ws;
  const u16* XN = (const u16*)(ws + WS_XN);
  const u16* WT = (const u16*)(ws + WS_WT_IN);
  u16* Q = (u16*)(ws + WS_Q);
  u16* KC = (u16*)(ws + WS_KC);
  u16* VC = (u16*)(ws + WS_VC);
  u16* KS = (u16*)(ws + WS_KS);
  u16* KW = (u16*)(ws + WS_KW);
  u16* VTS = (u16*)(ws + WS_VTS);
  u16* VTW = (u16*)(ws + WS_VTW);
  float* NG = (float*)(ws + WS_NG);
  u16* GLU = (u16*)(ws + WS_GLU);
  u16* MG = (u16*)(ws + WS_MG);
  const int tid = tid512(), lane = tid & 63, wave = tid >> 6;
  const int wm = wave >> 2, wn = wave & 3, lr = lane & 31, hh = lane >> 5;
  f32x16 acc[WM][2];
  zero_acc<WM>(acc);
  gemm512<WM>(acc, [&](int r) { return WT + (size_t)(n0 + r) * 1024; }, 64,
              [&](int r) { return XN + (size_t)(m0 + r) * 1024; }, 64, 16, smem);
  const int fw = n0 + wm * (WM * 32);
  const int tb = m0 + wn * 64 + lr;
  if (fw < 512) {
#pragma unroll
    for (int i = 0; i < WM; ++i)
#pragma unroll
      for (int j = 0; j < 2; ++j)
#pragma unroll
        for (int q4 = 0; q4 < 4; ++q4) {
          const int f = fw + i * 32 + q4 * 8 + hh * 4;
          const size_t t = tb + j * 32;
          const float sc = 0.125f * LOG2E;
          uint2 o;
          o.x = pack2(acc[i][j][q4 * 4 + 0] * sc, acc[i][j][q4 * 4 + 1] * sc);
          o.y = pack2(acc[i][j][q4 * 4 + 2] * sc, acc[i][j][q4 * 4 + 3] * sc);
          *(uint2*)(Q + t * 512 + f) = o;
        }
  } else if (fw < 1280) {
    const int sec = (fw - 512) >> 7;
    const int c0 = (fw - 512) & 127;
    if (sec == 3 || sec == 5) {
      u16* VT = (sec == 3) ? VTS : VTW;
#pragma unroll
      for (int i = 0; i < WM; ++i)
#pragma unroll
        for (int j = 0; j < 2; ++j)
#pragma unroll
          for (int e = 0; e < 16; ++e) {
            const int c = c0 + i * 32 + crow(e, hh);
            const int tt = tb + j * 32;
            const int b = tt >> 12, t = tt & 4095;
            VT[((size_t)(b * 128 + c)) * 4096 + swap23(t)] = f2bf(acc[i][j][e]);
          }
    } else {
      u16* dst = (sec == 0) ? KC : (sec == 1) ? VC : (sec == 2) ? KS : KW;
#pragma unroll
      for (int i = 0; i < WM; ++i)
#pragma unroll
        for (int j = 0; j < 2; ++j)
#pragma unroll
          for (int q4 = 0; q4 < 4; ++q4) {
            const int c = c0 + i * 32 + q4 * 8 + hh * 4;
            const size_t t = tb + j * 32;
            uint2 o;
            o.x = pack2(acc[i][j][q4 * 4 + 0], acc[i][j][q4 * 4 + 1]);
            o.y = pack2(acc[i][j][q4 * 4 + 2], acc[i][j][q4 * 4 + 3]);
            *(uint2*)(dst + t * 128 + c) = o;
          }
    }
  } else if (fw < 2304) {
    if (WM == 4) {
      const int blk = (fw - 1280) >> 7;
#pragma unroll
      for (int i = 0; i < 2; ++i)
#pragma unroll
        for (int j = 0; j < 2; ++j)
#pragma unroll
          for (int q4 = 0; q4 < 4; ++q4) {
            const int ch = blk * 64 + i * 32 + q4 * 8 + hh * 4;
            const size_t t = tb + j * 32;
            float u[4];
#pragma unroll
            for (int z = 0; z < 4; ++z) u[z] = acc[i][j][q4 * 4 + z] * sigmoidf_(acc[(i + 2) & (WM - 1)][j][q4 * 4 + z]);
            uint2 o;
            o.x = pack2(u[0], u[1]);
            o.y = pack2(u[2], u[3]);
            *(uint2*)(GLU + t * 512 + ch) = o;
          }
    }
  } else if (fw < 4352) {
#pragma unroll
    for (int i = 0; i < WM; ++i)
#pragma unroll
      for (int j = 0; j < 2; ++j)
#pragma unroll
        for (int q4 = 0; q4 < 4; ++q4) {
          const int f = fw - 2304 + i * 32 + q4 * 8 + hh * 4;
          const size_t t = tb + j * 32;
          uint2 o;
          o.x = pack2(sigmoidf_(acc[i][j][q4 * 4 + 0]), sigmoidf_(acc[i][j][q4 * 4 + 1]));
          o.y = pack2(sigmoidf_(acc[i][j][q4 * 4 + 2]), sigmoidf_(acc[i][j][q4 * 4 + 3]));
          *(uint2*)(MG + t * 2048 + f) = o;
        }
  } else if (fw == 4352) {
#pragma unroll
    for (int j = 0; j < 2; ++j)
#pragma unroll
      for (int q4 = 0; q4 < 3; ++q4) {
        const int f = q4 * 8 + hh * 4;
        const size_t t = tb + j * 32;
        float4 o;
        o.x = sigmoidf_(acc[0][j][q4 * 4 + 0]); o.y = sigmoidf_(acc[0][j][q4 * 4 + 1]);
        o.z = sigmoidf_(acc[0][j][q4 * 4 + 2]); o.w = sigmoidf_(acc[0][j][q4 * 4 + 3]);
        *(float4*)(NG + t * 32 + f) = o;
      }
  }
}

DI void phase_inproj(const Params& p, char* smem) {
  const int NT = NIN / 256;
  if (gridDim.x == 256) {
    const int x = blockIdx.x & 7, lb = blockIdx.x >> 3;
#pragma unroll 1
    for (int k = 0; k < 4; ++k) {
      const int r = lb + 32 * k;
      inproj_tile<4>(p, smem, (x * 8 + (r & 7)) * 256, (r >> 3) * 256);
    }
    const int r2 = 128 + (lb >> 1);
    inproj_tile<2>(p, smem, (x * 8 + (r2 & 7)) * 256, (r2 >> 3) * 256 + (lb & 1) * 128);
  } else {
    for (int kk = 0;; ++kk) {
      int mt, nt;
      if (!xcd_tile(kk, NT, 8, mt, nt)) break;
      inproj_tile<4>(p, smem, mt * 256, nt * 256);
    }
  }
}

DI void phase_compress(const Params& p, char* smem) {
  char* ws = p.ws;
  const u16* KC = (const u16*)(ws + WS_KC);
  const u16* VC = (const u16*)(ws + WS_VC);
  const u16* WT = (const u16*)(ws + WS_WT_C1);
  u16* KCMP = (u16*)(ws + WS_KCMP);
  u16* VCMPT = (u16*)(ws + WS_VCMPT);
  float* Hs = (float*)smem;
  const int tid = my_tid(), lane = tid & 63, wave = tid >> 6;
  const int lr = lane & 31, hh = lane >> 5;
  for (int it = vb_id(); it < 128; it += vb_n()) {
    const int kv = it & 1, mt = it >> 1;
    const u16* SRC = kv ? VC : KC;
    const float* pe = kv ? p.pe_v : p.pe_k;
    int mi = mt * 32 + lr;
    int bg = mi >> 8, n = mi & 255;
    if (n > 254) n = 254;
    const u16* arow = SRC + ((size_t)((bg >> 1) * 4096 + 16 * n)) * 128 + (bg & 1) * 64 + hh * 8;
    const u16* brow0 = WT + ((size_t)(kv * 64 + lr)) * 2048 + hh * 8;
    const u16* brow1 = brow0 + (size_t)32 * 2048;
    f32x16 acc0, acc1;
#pragma unroll
    for (int e = 0; e < 16; ++e) { acc0[e] = 0.f; acc1[e] = 0.f; }
#pragma unroll 4
    for (int sI = 0; sI < 32; ++sI) {
      const int s_ = wave * 32 + sI;
      const int l = s_ >> 2, d0 = (s_ & 3) * 16;
      u32x4 ar = *(const u32x4*)(arow + l * 128 + d0);
      float4 p0 = *(const float4*)(pe + l * 64 + d0 + hh * 8);
      float4 p1 = *(const float4*)(pe + l * 64 + d0 + hh * 8 + 4);
      bf16x8 b0 = *(const bf16x8*)(brow0 + s_ * 16);
      bf16x8 b1 = *(const bf16x8*)(brow1 + s_ * 16);
      u32x4 aw;
      aw[0] = pack2(bflo(ar[0]) + p0.x, bfhi(ar[0]) + p0.y);
      aw[1] = pack2(bflo(ar[1]) + p0.z, bfhi(ar[1]) + p0.w);
      aw[2] = pack2(bflo(ar[2]) + p1.x, bfhi(ar[2]) + p1.y);
      aw[3] = pack2(bflo(ar[3]) + p1.z, bfhi(ar[3]) + p1.w);
      bf16x8 a = __builtin_bit_cast(bf16x8, aw);
      acc0 = MFMA32(a, b0, acc0);
      acc1 = MFMA32(a, b1, acc1);
    }
    hsync();
#pragma unroll
    for (int e = 0; e < 16; ++e) {
      Hs[(wave * 32 + crow(e, hh)) * 65 + lr] = acc0[e];
      Hs[(wave * 32 + crow(e, hh)) * 65 + 32 + lr] = acc1[e];
    }
    hsync();
    const int row = tid >> 3, c0 = (tid & 7) * 8;
#pragma unroll
    for (int c = 0; c < 8; ++c) {
      float h = Hs[row * 65 + c0 + c] + Hs[(32 + row) * 65 + c0 + c] + Hs[(64 + row) * 65 + c0 + c] + Hs[(96 + row) * 65 + c0 + c];
      Hs[row * 65 + c0 + c] = gelu_exact(h);
    }
    hsync();
    {
      const float* w2 = kv ? p.w_v2 : p.w_k2;
      float o[8];
#pragma unroll
      for (int c = 0; c < 8; ++c) o[c] = 0.f;
#pragma unroll 8
      for (int i = 0; i < 64; ++i) {
        float hv = Hs[row * 65 + i];
        float4 wa = *(const float4*)(w2 + i * 64 + c0);
        float4 wb = *(const float4*)(w2 + i * 64 + c0 + 4);
        o[0] += hv * wa.x; o[1] += hv * wa.y; o[2] += hv * wa.z; o[3] += hv * wa.w;
        o[4] += hv * wb.x; o[5] += hv * wb.y; o[6] += hv * wb.z; o[7] += hv * wb.w;
      }
      int mi2 = mt * 32 + row;
      int bg2 = mi2 >> 8, n2 = mi2 & 255;
      if (n2 == 255) {
#pragma unroll
        for (int c = 0; c < 8; ++c) o[c] = 0.f;
      }
      if (kv == 0) {
        u32x4 w;
        w[0] = pack2(o[0], o[1]); w[1] = pack2(o[2], o[3]); w[2] = pack2(o[4], o[5]); w[3] = pack2(o[6], o[7]);
        *(u32x4*)(KCMP + ((size_t)(bg2 * 256 + n2)) * 64 + c0) = w;
      } else {
#pragma unroll
        for (int c = 0; c < 8; ++c) VCMPT[((size_t)(bg2 * 64 + c0 + c)) * 256 + swap23(n2)] = f2bf(o[c]);
      }
    }
    hsync();
  }
}

template <int KSTRIDE, bool WIN, int MASK, int MODE>
DI void attend_tile(const u16* Ks, const u16* Vts, const bf16x8 (&qf)[4], f32x16 (&O)[2], float& m, float& l, int dbase,
                    float slope2, bool lanesel, float invl, unsigned* imp_row, int mbase, int lr, int hh) {
  f32x16 s[2];
#pragma unroll
  for (int kt = 0; kt < 2; ++kt) {
#pragma unroll
    for (int e = 0; e < 16; ++e) s[kt][e] = 0.f;
#pragma unroll
    for (int ks = 0; ks < 4; ++ks) {
      bf16x8 a = *(const bf16x8*)(Ks + (kt * 32 + lr) * 72 + ks * 16 + hh * 8);
      s[kt] = MFMA32(a, qf[ks], s[kt]);
    }
  }
  const float fd0 = (float)(dbase - KSTRIDE * 4 * hh);
  const float ct = slope2 * fd0;
  float mx = -1e30f;
#pragma unroll
  for (int kt = 0; kt < 2; ++kt)
#pragma unroll
    for (int e = 0; e < 16; ++e) {
      const float Ke = (float)(KSTRIDE * (kt * 32 + (e & 3) + 8 * (e >> 2)));
      float v = fmaf(slope2, Ke, s[kt][e]);
      if (MASK == 1) {
        const float fd = fd0 - Ke;
        bool valid = fd >= 0.f;
        if (WIN) valid = valid && (fd < 512.f);
        valid = valid && lanesel;
        v = valid ? v : -1e30f;
      }
      s[kt][e] = v;
      mx = fmaxf(mx, v);
    }
  mx = (mx > -1e29f) ? mx - ct : -1e30f;
  mx = fmaxf(mx, __shfl_xor(mx, 32));
  if (MASK == 2) mx = lanesel ? mx : -1e30f;
  float mnew = m, alpha = 1.f;
  if (MODE != 2) {
    mnew = fmaxf(m, mx);
    alpha = fexp2(m - mnew);
    m = mnew;
  }
  float shift = mnew + ct;
  if (MASK == 2) shift = lanesel ? shift : 1e30f;
  float rs = 0.f;
#pragma unroll
  for (int kt = 0; kt < 2; ++kt)
#pragma unroll
    for (int e = 0; e < 16; ++e) {
      float v = s[kt][e];
      float pv;
      if (MASK == 1) pv = (v > -1e29f) ? fexp2(v - shift) : 0.f;
      else pv = fexp2(v - shift);
      if (MODE == 2) pv *= invl;
      s[kt][e] = pv;
      rs += pv;
    }
  if (MODE != 2) l = l * alpha + rs;
  if (MODE == 1) return;
  if (MODE == 0) {
#pragma unroll
    for (int e = 0; e < 16; ++e) { O[0][e] *= alpha; O[1][e] *= alpha; }
  }
  if (MODE == 2) {
#pragma unroll
    for (int kt = 0; kt < 2; ++kt)
#pragma unroll
      for (int q4 = 0; q4 < 4; ++q4) {
        float qsum = s[kt][q4 * 4] + s[kt][q4 * 4 + 1] + s[kt][q4 * 4 + 2] + s[kt][q4 * 4 + 3];
        float last = s[kt][q4 * 4 + 3];
        int mi = mbase + kt * 8 + 2 * q4 + hh;
        atomicAdd(imp_row + mi, (unsigned)(qsum * 67108864.f + 0.5f));
        if (mi + 1 < 64) atomicAdd(imp_row + mi + 1, (unsigned)(last * 67108864.f + 0.5f));
      }
  }
#pragma unroll
  for (int kt = 0; kt < 2; ++kt)
#pragma unroll
    for (int sx = 0; sx < 2; ++sx) {
      unsigned pk[4];
#pragma unroll
      for (int q = 0; q < 4; ++q) pk[q] = pack2(s[kt][8 * sx + 2 * q], s[kt][8 * sx + 2 * q + 1]);
      bf16x8 pb;
      {
        u32x4 t4 = {pk[0], pk[1], pk[2], pk[3]};
        pb = __builtin_bit_cast(bf16x8, t4);
      }
#pragma unroll
      for (int dt = 0; dt < 2; ++dt) {
        bf16x8 a = *(const bf16x8*)(Vts + (dt * 32 + lr) * 72 + kt * 32 + 16 * sx + 8 * hh);
        O[dt] = MFMA32(a, pb, O[dt]);
      }
    }
}

struct KVRegs { u32x4 k[2], v[2]; };
DI void kv_issue(KVRegs& r, const u16* ksrc, int kstride, const u16* vsrc, int vstride, int tid) {
#pragma unroll
  for (int i = 0; i < 2; ++i) {
    int c = tid + 256 * i;
    int row = c >> 3, ch = (c & 7) * 8;
    r.k[i] = *(const u32x4*)(ksrc + (size_t)row * kstride + ch);
    r.v[i] = *(const u32x4*)(vsrc + (size_t)row * vstride + ch);
  }
}
DI void kv_commit(const KVRegs& r, u16* Ks, u16* Vts, int tid) {
#pragma unroll
  for (int i = 0; i < 2; ++i) {
    int c = tid + 256 * i;
    int row = c >> 3, ch = (c & 7) * 8;
    *(u32x4*)(Ks + row * 72 + ch) = r.k[i];
    *(u32x4*)(Vts + row * 72 + ch) = r.v[i];
  }
  hsync();
}

DI void attn_item(const Params& p, int item, char* smem) {
  char* ws = p.ws;
  const u16* Q = (const u16*)(ws + WS_Q);
  const u16* KS = (const u16*)(ws + WS_KS);
  const u16* KW = (const u16*)(ws + WS_KW);
  const u16* VTS = (const u16*)(ws + WS_VTS);
  const u16* VTW = (const u16*)(ws + WS_VTW);
  const u16* KCMP = (const u16*)(ws + WS_KCMP);
  const u16* VCMPT = (const u16*)(ws + WS_VCMPT);
  const float* NG = (const float*)(ws + WS_NG);
  u16* ONSA = (u16*)p.out;

  u16* KsB = (u16*)smem;
  int pb = 0;
#define Ks (KsB + pb * (2 * 64 * 72))
#define Vts (KsB + pb * (2 * 64 * 72) + 64 * 72)
  unsigned* imp_s = (unsigned*)(KsB + 4 * 64 * 72);
  unsigned char* sel8 = (unsigned char*)(imp_s + 32 * 65);

  const int tid = my_tid(), lane = tid & 63, wave = tid >> 6;
  const int lr = lane & 31, hh = lane >> 5;
  const int bg = item & 7, q32 = 127 - (item >> 3);
  const int b = bg >> 1, g = bg & 1;
  const int t0 = q32 * 32;
  const int head = g * 4 + wave;
  const int t = t0 + lr;
  const size_t row = (size_t)b * 4096 + t;
  const int qb = t0 >> 6;

  bf16x8 qf[4];
#pragma unroll
  for (int ks = 0; ks < 4; ++ks) qf[ks] = *(const bf16x8*)(Q + row * 512 + head * 64 + ks * 16 + hh * 8);
  float* ot_s = (float*)(sel8 + 256) + wave * 32 * 64 + lane;
  const float slope2 = fexp2(-(float)(head + 1)) * LOG2E;
  const float gc = NG[row * 32 + head], gs = NG[row * 32 + 8 + head], gw = NG[row * 32 + 16 + head];

  f32x16 O[2];

  hsync();
  for (int i = tid; i < 32 * 65; i += 256) imp_s[i] = 0u;

  const int nct = t0 / 1024 + 1;
  float m = -1e30f, l = 0.f;
  KVRegs kvr;
  kv_issue(kvr, KCMP + ((size_t)(bg * 256)) * 64, 64, VCMPT + (size_t)bg * 64 * 256, 256, tid);
#pragma unroll 1
  for (int c = 0; c < nct; ++c) {
    kv_commit(kvr, Ks, Vts, tid);
    const int cn = (c + 1 < nct) ? c + 1 : 0;
    kv_issue(kvr, KCMP + ((size_t)(bg * 256 + 64 * cn)) * 64, 64, VCMPT + (size_t)bg * 64 * 256 + 64 * cn, 256, tid);
    attend_tile<16, false, 1, 1>(Ks, Vts, qf, O, m, l, t - (31 + 1024 * c), slope2, true, 0.f, nullptr, 0, lr, hh);
    pb ^= 1;
  }
  {
    float lt = l + __shfl_xor(l, 32);
    float invl = lt > 0.f ? 1.f / lt : 0.f;
#pragma unroll
    for (int e = 0; e < 16; ++e) { O[0][e] = 0.f; O[1][e] = 0.f; }
#pragma unroll 1
    for (int c = 0; c < nct; ++c) {
      kv_commit(kvr, Ks, Vts, tid);
      if (c + 1 < nct) kv_issue(kvr, KCMP + ((size_t)(bg * 256 + 64 * (c + 1))) * 64, 64, VCMPT + (size_t)bg * 64 * 256 + 64 * (c + 1), 256, tid);
      attend_tile<16, false, 1, 2>(Ks, Vts, qf, O, m, l, t - (31 + 1024 * c), slope2, true, invl, imp_s + lr * 65,
                                        c * 16, lr, hh);
      pb ^= 1;
    }
#pragma unroll
    for (int e = 0; e < 16; ++e) { ot_s[e * 64] = O[0][e] * gc; ot_s[(16 + e) * 64] = O[1][e] * gc; }
  }
  hsync();
  {
    const int tl = tid >> 3, part = tid & 7;
    unsigned bits = 0;
    if (qb <= 15) {
#pragma unroll
      for (int jj = 0; jj < 8; ++jj) if (part * 8 + jj <= qb) bits |= 1u << jj;
    } else {
      unsigned mine[8];
      int cnt[8];
#pragma unroll
      for (int jj = 0; jj < 8; ++jj) { mine[jj] = imp_s[tl * 65 + part * 8 + jj]; cnt[jj] = 0; }
      for (int jp = 1; jp <= qb - 2; ++jp) {
        unsigned v = imp_s[tl * 65 + jp];
#pragma unroll
        for (int jj = 0; jj < 8; ++jj) {
          int j = part * 8 + jj;
          cnt[jj] += ((v > mine[jj]) || (v == mine[jj] && jp < j)) ? 1 : 0;
        }
      }
#pragma unroll
      for (int jj = 0; jj < 8; ++jj) {
        int j = part * 8 + jj;
        bool f = (j == 0) || (j == qb) || (j == qb - 1);
        bool c = (j >= 1) && (j <= qb - 2) && (cnt[jj] < 13);
        if (f || c) bits |= 1u << jj;
      }
    }
    sel8[tl * 8 + part] = (unsigned char)bits;
  }
  hsync();
  {
    const unsigned* sel32 = (const unsigned*)sel8;
    const unsigned mylo = sel32[lr * 2], myhi = sel32[lr * 2 + 1];
    unsigned alo = mylo, ahi = myhi;
#pragma unroll
    for (int o = 16; o > 0; o >>= 1) { alo |= __shfl_xor(alo, o); ahi |= __shfl_xor(ahi, o); }
    alo = __builtin_amdgcn_readfirstlane(alo);
    ahi = __builtin_amdgcn_readfirstlane(ahi);
    m = -1e30f; l = 0.f;
#pragma unroll
    for (int e = 0; e < 16; ++e) { O[0][e] = 0.f; O[1][e] = 0.f; }
    u64 am = ((u64)ahi << 32) | (u64)alo;
    int j = -1;
    if (am) { j = __builtin_ctzll(am); am &= am - 1; }
    if (j >= 0) kv_issue(kvr, KS + ((size_t)(b * 4096 + 64 * j)) * 128 + g * 64, 128, VTS + (size_t)bg * 64 * 4096 + 64 * j, 4096, tid);
#pragma unroll 1
    while (j >= 0) {
      kv_commit(kvr, Ks, Vts, tid);
      int jn = -1;
      if (am) { jn = __builtin_ctzll(am); am &= am - 1; }
      if (jn >= 0) kv_issue(kvr, KS + ((size_t)(b * 4096 + 64 * jn)) * 128 + g * 64, 128, VTS + (size_t)bg * 64 * 4096 + 64 * jn, 4096, tid);
      bool ls = (j < 32) ? ((mylo >> j) & 1u) : ((myhi >> (j - 32)) & 1u);
      if (j < qb) attend_tile<1, false, 2, 0>(Ks, Vts, qf, O, m, l, t - 64 * j, slope2, ls, 0.f, nullptr, 0, lr, hh);
      else attend_tile<1, false, 1, 0>(Ks, Vts, qf, O, m, l, t - 64 * j, slope2, ls, 0.f, nullptr, 0, lr, hh);
      pb ^= 1;
      j = jn;
    }
    float lt = l + __shfl_xor(l, 32);
    float sc = lt > 0.f ? gs / lt : 0.f;
#pragma unroll
    for (int e = 0; e < 16; ++e) { ot_s[e * 64] += O[0][e] * sc; ot_s[(16 + e) * 64] += O[1][e] * sc; }
  }
  {
    m = -1e30f; l = 0.f;
#pragma unroll
    for (int e = 0; e < 16; ++e) { O[0][e] = 0.f; O[1][e] = 0.f; }
    const int kbase = (t0 & ~63) - 512;
    int i0 = 0;
    if (kbase < 0) i0 = (-kbase) >> 6;
    kv_issue(kvr, KW + ((size_t)(b * 4096 + kbase + 64 * i0)) * 128 + g * 64, 128, VTW + (size_t)bg * 64 * 4096 + kbase + 64 * i0, 4096, tid);
#pragma unroll 1
    for (int i = i0; i < 9; ++i) {
      const int k0 = kbase + 64 * i;
      kv_commit(kvr, Ks, Vts, tid);
      if (i + 1 < 9) kv_issue(kvr, KW + ((size_t)(b * 4096 + k0 + 64)) * 128 + g * 64, 128, VTW + (size_t)bg * 64 * 4096 + k0 + 64, 4096, tid);
      if (i >= 1 && i <= 7) attend_tile<1, false, 0, 0>(Ks, Vts, qf, O, m, l, t - k0, slope2, true, 0.f, nullptr, 0, lr, hh);
      else attend_tile<1, true, 1, 0>(Ks, Vts, qf, O, m, l, t - k0, slope2, true, 0.f, nullptr, 0, lr, hh);
      pb ^= 1;
    }
    float lt = l + __shfl_xor(l, 32);
    float sc = lt > 0.f ? gw / lt : 0.f;
#pragma unroll
    for (int e = 0; e < 16; ++e) { O[0][e] = ot_s[e * 64] + O[0][e] * sc; O[1][e] = ot_s[(16 + e) * 64] + O[1][e] * sc; }
  }
#pragma unroll
  for (int dt = 0; dt < 2; ++dt)
#pragma unroll
    for (int q4 = 0; q4 < 4; ++q4) {
      int d0 = dt * 32 + q4 * 8 + hh * 4;
      uint2 o;
      o.x = pack2(O[dt][q4 * 4 + 0], O[dt][q4 * 4 + 1]);
      o.y = pack2(O[dt][q4 * 4 + 2], O[dt][q4 * 4 + 3]);
      *(uint2*)(ONSA + row * 512 + head * 64 + d0) = o;
    }
  hsync();
}

#undef Ks
#undef Vts

DI void conv_item(const Params& p, int item, char* smem) {
  char* ws = p.ws;
  const u16* GLU = (const u16*)(ws + WS_GLU);
  u16* CACT = (u16*)p.out + (size_t)T_TOK * 512;
  float* cs = (float*)smem;
  const int tid = my_tid(), lane = tid & 63, wave = tid >> 6;
  const int b = item >> 8, t0 = (item & 255) * 16;
  const int c0 = tid * 2;
  const float2 bias = *(const float2*)(p.b_dw + c0);
  unsigned rowv[46];
#pragma unroll
  for (int r = 0; r < 46; ++r) {
    int tt = t0 - 30 + r;
    rowv[r] = 0u;
    if (tt >= 0) rowv[r] = *(const unsigned*)(GLU + ((size_t)(b * 4096 + tt)) * 512 + c0);
  }
  hsync();
#pragma unroll
  for (int pass = 0; pass < 2; ++pass) {
    float w[31];
#pragma unroll
    for (int k = 0; k < 31; ++k) w[k] = p.w_dw[k * 512 + c0 + pass];
#pragma unroll
    for (int tl = 0; tl < 16; ++tl) {
      float a0 = pass ? bias.y : bias.x;
#pragma unroll
      for (int k = 0; k < 31; ++k) a0 += w[k] * (pass ? bfhi(rowv[tl + k]) : bflo(rowv[tl + k]));
      cs[tl * 520 + c0 + pass] = a0;
    }
  }
  hsync();
#pragma unroll
  for (int q = 0; q < 4; ++q) {
    const int tl = wave * 4 + q;
    float v[8];
    float sum = 0.f;
#pragma unroll
    for (int i = 0; i < 8; ++i) { v[i] = cs[tl * 520 + lane + 64 * i]; sum += v[i]; }
    float mean = wave_sum(sum) * (1.f / 512.f);
    float sq = 0.f;
#pragma unroll
    for (int i = 0; i < 8; ++i) { float d = v[i] - mean; sq += d * d; }
    float rstd = rsqrtf(wave_sum(sq) * (1.f / 512.f) + 1e-6f);
#pragma unroll
    for (int i = 0; i < 8; ++i) {
      int c = lane + 64 * i;
      float y = (v[i] - mean) * rstd * p.g_ln[c] + p.b_ln[c];
      float sl = y * sigmoidf_(y);
      CACT[((size_t)(b * 4096 + t0 + tl)) * 512 + c] = f2bf(sl);
    }
  }
  hsync();
}

DI void phase_mix(const Params& p, char* smem) {
  {
    int rnd = 0;
    for (int it = vb_id(); it < 1024; it += vb_n(), ++rnd) {
      const int item = (rnd & 1) ? (1023 - (it - rnd * vb_n())) - ((rnd - 1) * vb_n()) : it;
      if (item >= 0 && item < 1024) attn_item(p, item, smem);
    }
  }
  for (int it = vb_id(); it < 1024; it += vb_n()) conv_item(p, it, smem);
}

DI void phase_merge(const Params& p, char* smem) {
  char* ws = p.ws;
  const u16* ONSA = (const u16*)p.out;
  const u16* CACT = (const u16*)p.out + (size_t)T_TOK * 512;
  const u16* WA = (const u16*)(ws + WS_WT_NSA);
  const u16* WB = (const u16*)(ws + WS_WT_CONV);
  const u16* MG = (const u16*)(ws + WS_MG);
  u16* MERGED = (u16*)(ws + WS_XN);
  const int tid = tid512(), lane = tid & 63, wave = tid >> 6;
  const int wm = wave >> 2, wn = wave & 3, lr = lane & 31, hh = lane >> 5;
  for (int kk = 0;; ++kk) {
    int mt, nt;
    if (!xcd_tile(kk, 8, 8, mt, nt)) break;
    const int m0 = mt * 256, n0 = nt * 128;
    f32x16 ya[2][2], yb[2][2];
    zero_acc<2>(ya);
    zero_acc<2>(yb);
    gemm512<2>(ya, [&](int r) { return WA + (size_t)(n0 + r) * 512; }, 64, [&](int r) { return ONSA + (size_t)(m0 + r) * 512; }, 64, 8, smem);
    gemm512<2>(yb, [&](int r) { return WB + (size_t)(n0 + r) * 512; }, 64, [&](int r) { return CACT + (size_t)(m0 + r) * 512; }, 64, 8, smem);
#pragma unroll
    for (int i = 0; i < 2; ++i)
#pragma unroll
      for (int j = 0; j < 2; ++j)
#pragma unroll
        for (int q4 = 0; q4 < 4; ++q4) {
          const int f = n0 + wm * 64 + i * 32 + q4 * 8 + hh * 4;
          const size_t t = m0 + wn * 64 + j * 32 + lr;
          const uint2 ga = *(const uint2*)(MG + t * 2048 + f);
          const uint2 gb = *(const uint2*)(MG + t * 2048 + 1024 + f);
          uint2 o;
          o.x = pack2(bflo(ga.x) * ya[i][j][q4 * 4 + 0] + bflo(gb.x) * yb[i][j][q4 * 4 + 0],
                      bfhi(ga.x) * ya[i][j][q4 * 4 + 1] + bfhi(gb.x) * yb[i][j][q4 * 4 + 1]);
          o.y = pack2(bflo(ga.y) * ya[i][j][q4 * 4 + 2] + bflo(gb.y) * yb[i][j][q4 * 4 + 2],
                      bfhi(ga.y) * ya[i][j][q4 * 4 + 3] + bfhi(gb.y) * yb[i][j][q4 * 4 + 3]);
          *(uint2*)(MERGED + t * 1024 + f) = o;
        }
  }
}

DI void phase_wo(const Params& p, char* smem) {
  char* ws = p.ws;
  const u16* MERGED = (const u16*)(ws + WS_XN);
  const u16* WT = (const u16*)(ws + WS_WT_O);
  float* X1 = p.out;
  const int tid = tid512(), lane = tid & 63, wave = tid >> 6;
  const int wm = wave >> 2, wn = wave & 3, lr = lane & 31, hh = lane >> 5;
  for (int kk = 0;; ++kk) {
    int mt, nt;
    if (!xcd_tile(kk, 4, 8, mt, nt)) break;
    const int m0 = mt * 256, n0 = nt * 256;
    f32x16 acc[4][2];
    zero_acc<4>(acc);
    gemm512<4>(acc, [&](int r) { return WT + (size_t)(n0 + r) * 1024; }, 64, [&](int r) { return MERGED + (size_t)(m0 + r) * 1024; }, 64, 16, smem);
#pragma unroll
    for (int i = 0; i < 4; ++i)
#pragma unroll
      for (int j = 0; j < 2; ++j)
#pragma unroll
        for (int q4 = 0; q4 < 4; ++q4) {
          const int f = n0 + wm * 128 + i * 32 + q4 * 8 + hh * 4;
          const size_t t = m0 + wn * 64 + j * 32 + lr;
          float4 xv = *(const float4*)(p.x + t * 1024 + f);
          xv.x += acc[i][j][q4 * 4 + 0]; xv.y += acc[i][j][q4 * 4 + 1];
          xv.z += acc[i][j][q4 * 4 + 2]; xv.w += acc[i][j][q4 * 4 + 3];
          *(float4*)(X1 + t * 1024 + f) = xv;
        }
  }
}

DI void phase_norm2(const Params& p) {
  const int tid = my_tid(); const int lane = tid & 63, wave = tid >> 6;
  u16* XN2 = (u16*)(p.ws + WS_Q);
  for (int it = vb_id(); it < 1024; it += vb_n()) {
    int row = it * 16 + wave * 4;
    rms_rows<4>(p.out + (size_t)row * 1024, p.g_ffn, XN2 + (size_t)row * 1024, lane);
  }
}

DI void phase_pq(const Params& p, char* smem) {
  char* ws = p.ws;
  const u16* XN2 = (const u16*)(ws + WS_Q);
  const u16* WT = (const u16*)(ws + WS_WT_PQ);
  u16* PQ = (u16*)(ws + WS_MG);
  const int tid = tid512(), lane = tid & 63, wave = tid >> 6;
  const int wm = wave >> 2, wn = wave & 3, lr = lane & 31, hh = lane >> 5;
  for (int kk = 0;; ++kk) {
    int mt, nt;
    if (!xcd_tile(kk, 8, 8, mt, nt)) break;
    const int m0 = mt * 256, n0 = nt * 256;
    f32x16 acc[4][2];
    zero_acc<4>(acc);
    gemm512<4>(acc, [&](int r) { return WT + (size_t)(n0 + r) * 1024; }, 64, [&](int r) { return XN2 + (size_t)(m0 + r) * 1024; }, 64, 16, smem);
#pragma unroll
    for (int i = 0; i < 4; ++i)
#pragma unroll
      for (int j = 0; j < 2; ++j)
#pragma unroll
        for (int q4 = 0; q4 < 4; ++q4) {
          const int f = n0 + wm * 128 + i * 32 + q4 * 8 + hh * 4;
          const size_t t = m0 + wn * 64 + j * 32 + lr;
          uint2 o;
          o.x = pack2(acc[i][j][q4 * 4 + 0], acc[i][j][q4 * 4 + 1]);
          o.y = pack2(acc[i][j][q4 * 4 + 2], acc[i][j][q4 * 4 + 3]);
          *(uint2*)(PQ + t * 2048 + f) = o;
        }
  }
}

template <int LOGN>
DI void bitonic_sort_desc(unsigned (&a)[1 << LOGN]) {
  constexpr int N = 1 << LOGN;
#pragma unroll
  for (int ks = 1; ks <= LOGN; ++ks)
#pragma unroll
    for (int js = ks - 1; js >= 0; --js)
#pragma unroll
      for (int i = 0; i < N; ++i) {
        const int k = 1 << ks, j = 1 << js, l = i ^ j;
        if (l > i) {
          const bool desc = ((i & k) == 0) || (ks == LOGN);
          const unsigned x = a[i], y = a[l];
          const unsigned hi = max(x, y), lo = min(x, y);
          a[i] = desc ? hi : lo;
          a[l] = desc ? lo : hi;
        }
      }
}
DI void merge_top16(unsigned (&a)[16], const unsigned (&b)[16]) {
#pragma unroll
  for (int i = 0; i < 16; ++i) a[i] = max(a[i], b[15 - i]);
#pragma unroll
  for (int js = 3; js >= 0; --js)
#pragma unroll
    for (int i = 0; i < 16; ++i) {
      const int j = 1 << js, l = i ^ j;
      if (l > i) {
        const unsigned x = a[i], y = a[l];
        a[i] = max(x, y);
        a[l] = min(x, y);
      }
    }
}

DI void peer_top16(const u16* __restrict__ PQrow, const u16* __restrict__ SK, unsigned (&top)[16], int lr, int hh) {
  bf16x8 qf[8];
#pragma unroll
  for (int ks = 0; ks < 8; ++ks) qf[ks] = *(const bf16x8*)(PQrow + ks * 16 + hh * 8);
  unsigned g[4][16];
#pragma unroll
  for (int kt = 0; kt < 4; ++kt) {
    f32x16 acc;
#pragma unroll
    for (int e = 0; e < 16; ++e) acc[e] = 0.f;
#pragma unroll
    for (int ks = 0; ks < 8; ++ks) {
      bf16x8 a = *(const bf16x8*)(SK + (size_t)(kt * 32 + lr) * 128 + ks * 16 + hh * 8);
      acc = MFMA32(a, qf[ks], acc);
    }
#pragma unroll
    for (int e = 0; e < 16; ++e) {
      int kidx = kt * 32 + crow(e, hh);
      g[kt][e] = (f2ord(acc[e]) & ~127u) | (unsigned)(127 - kidx);
    }
    bitonic_sort_desc<4>(g[kt]);
  }
  merge_top16(g[0], g[1]);
  merge_top16(g[2], g[3]);
  merge_top16(g[0], g[2]);
  unsigned other[16];
#pragma unroll
  for (int i = 0; i < 16; ++i) other[i] = (unsigned)__shfl_xor((int)g[0][i], 32);
  merge_top16(g[0], other);
#pragma unroll
  for (int i = 0; i < 16; ++i) top[i] = g[0][i];
}

template <bool STORE>
DI void peer_item(const Params& p, int item, char* smem) {
  char* ws = p.ws;
  const u16* PQ = (const u16*)(ws + WS_MG);
  const u16* SUBK = (const u16*)(ws + WS_SUBK);
  const u16* XN2 = (const u16*)(ws + WS_Q);
  int* e_s = (int*)smem;
  float* g_s = (float*)(e_s + 32 * 128);
  const int tid = my_tid(), lane = tid & 63, wave = tid >> 6;
  const int lr = lane & 31, hh = lane >> 5;
  const int tok0 = item * 32;
  hsync();
  for (int hq = 0; hq < 2; ++hq) {
    const int hd = wave * 2 + hq;
    unsigned top1[16], top2[16];
    const u16* pqrow = PQ + (size_t)(tok0 + lr) * 2048 + hd * 256;
    peer_top16(pqrow, SUBK + (size_t)(hd * 2 + 0) * 128 * 128, top1, lr, hh);
    peer_top16(pqrow + 128, SUBK + (size_t)(hd * 2 + 1) * 128 * 128, top2, lr, hh);
    unsigned ckey[16][16];
#pragma unroll
    for (int a = 0; a < 16; ++a)
#pragma unroll
      for (int bq = 0; bq < 16; ++bq)
        if ((a + 1) * (bq + 1) <= 16)
          ckey[a][bq] = (f2ord(ord2f(top1[a] & ~127u) + ord2f(top2[bq] & ~127u)) & ~255u) | (unsigned)(255 - (a * 16 + bq));
    unsigned wkey[16];
    int we[16];
#pragma unroll
    for (int r = 0; r < 16; ++r) {
      unsigned mx = 0u;
#pragma unroll
      for (int a = 0; a < 16; ++a)
#pragma unroll
        for (int bq = 0; bq < 16; ++bq)
          if ((a + 1) * (bq + 1) <= 16) mx = max(mx, ckey[a][bq]);
#pragma unroll
      for (int a = 0; a < 16; ++a)
#pragma unroll
        for (int bq = 0; bq < 16; ++bq)
          if ((a + 1) * (bq + 1) <= 16) ckey[a][bq] = (ckey[a][bq] == mx) ? 0u : ckey[a][bq];
      wkey[r] = mx;
      const int cidx = 255 - (int)(mx & 255u);
      const int wa = cidx >> 4, wb = cidx & 15;
      unsigned t1 = top1[0], t2 = top2[0];
#pragma unroll
      for (int a = 1; a < 16; ++a) { t1 = (wa == a) ? top1[a] : t1; t2 = (wb == a) ? top2[a] : t2; }
      we[r] = (127 - (int)(t1 & 127u)) * 128 + (127 - (int)(t2 & 127u));
    }
    float cs0 = ord2f(wkey[0] & ~255u);
    float ex[16], sum = 0.f;
#pragma unroll
    for (int r = 0; r < 16; ++r) { ex[r] = __expf(ord2f(wkey[r] & ~255u) - cs0); sum += ex[r]; }
    float inv = 1.f / sum;
    if (hh == 0) {
#pragma unroll
      for (int r = 0; r < 16; ++r) {
        e_s[lr * 128 + hd * 16 + r] = we[r];
        g_s[lr * 128 + hd * 16 + r] = ex[r] * inv;
      }
    }
  }
  hsync();
  const unsigned char* U8 = (const unsigned char*)(ws + WS_UBF);
  const float* SU = (const float*)(ws + WS_SU);
  const float* SV = (const float*)(ws + WS_SV);
  int* EG = (int*)(ws + WS_XN);
  float* AG = (float*)(ws + WS_XN + (size_t)T_TOK * 128 * 4);
  const bool b5 = (lane & 32) != 0, b4 = (lane & 16) != 0, b3 = (lane & 8) != 0;
#pragma unroll 1
  for (int ti = 0; ti < 8; ++ti) {
    const int tl = wave * 8 + ti;
    const size_t tok = (size_t)tok0 + tl;
    float xf[16];
    {
#pragma unroll
      for (int i = 0; i < 4; ++i) {
        const uint2 xv = *(const uint2*)(XN2 + tok * 1024 + 256 * i + lane * 4);
        xf[4 * i] = bflo(xv.x); xf[4 * i + 1] = bfhi(xv.x); xf[4 * i + 2] = bflo(xv.y); xf[4 * i + 3] = bfhi(xv.y);
      }
    }
#pragma unroll 2
    for (int k = 0; k < 128; k += 8) {
      u32x4 uq[8];
      const int emine = e_s[tl * 128 + k + (lane >> 3)];
      const float gmine = g_s[tl * 128 + k + (lane >> 3)];
      const float su = SU[emine], sv = SV[emine];
#pragma unroll
      for (int u = 0; u < 8; ++u) {
        int e = e_s[tl * 128 + k + u];
        uq[u] = *(const u32x4*)(U8 + (size_t)e * 1024 + lane * 16);
      }
      float part[8];
#pragma unroll
      for (int u = 0; u < 8; ++u) {
        float d = 0.f;
#pragma unroll
        for (int i = 0; i < 4; ++i) {
          f32x2_t lo = __builtin_amdgcn_cvt_pk_f32_fp8((int)uq[u][i], false);
          f32x2_t hi = __builtin_amdgcn_cvt_pk_f32_fp8((int)uq[u][i], true);
          d += xf[4 * i] * lo.x + xf[4 * i + 1] * lo.y + xf[4 * i + 2] * hi.x + xf[4 * i + 3] * hi.y;
        }
        part[u] = d;
      }
      float q4[4], r2[2], h;
#pragma unroll
      for (int j = 0; j < 4; ++j) {
        float mine = b5 ? part[j + 4] : part[j];
        float other = b5 ? part[j] : part[j + 4];
        q4[j] = mine + __shfl_xor(other, 32);
      }
#pragma unroll
      for (int j = 0; j < 2; ++j) {
        float mine = b4 ? q4[j + 2] : q4[j];
        float other = b4 ? q4[j] : q4[j + 2];
        r2[j] = mine + __shfl_xor(other, 16);
      }
      {
        float mine = b3 ? r2[1] : r2[0];
        float other = b3 ? r2[0] : r2[1];
        h = mine + dpp_f<0x128>(other);
      }
      h += dpp_f<0x141>(h);
      h += dpp_f<0xB1>(h);
      h += dpp_f<0x4E>(h);
      const float amine = gelu_exact(h * su) * gmine * sv;
      if ((lane & 7) == 0) {
        EG[tok * 128 + k + (lane >> 3)] = emine;
        AG[tok * 128 + k + (lane >> 3)] = amine;
      }
    }
  }
  hsync();
}

DI void peer_item_v(const Params& p, int item) {
  char* ws = p.ws;
  const unsigned char* V8 = (const unsigned char*)(ws + WS_VBF);
  const int* EG = (const int*)(ws + WS_XN);
  const float* AG = (const float*)(ws + WS_XN + (size_t)T_TOK * 128 * 4);
  const int tid = my_tid(), lane = tid & 63, wave = tid >> 6;
#pragma unroll 1
  for (int ti = 0; ti < 8; ++ti) {
    const size_t tok = (size_t)item * 32 + wave * 8 + ti;
    const int e_lo = EG[tok * 128 + lane], e_hi = EG[tok * 128 + 64 + lane];
    const int a_lo = __float_as_int(AG[tok * 128 + lane]), a_hi = __float_as_int(AG[tok * 128 + 64 + lane]);
    float out[16];
#pragma unroll
    for (int i = 0; i < 16; ++i) out[i] = 0.f;
    u32x4 vqa[8], vqb[8];
#define V_ISSUE(VQ, G)                                                                              \
    {                                                                                                \
      const int g_ = (G);                                                                            \
      _Pragma("unroll") for (int u = 0; u < 8; ++u) {                                                \
        const int e = (g_ < 8) ? __builtin_amdgcn_readlane(e_lo, (g_ & 7) * 8 + u)                   \
                               : __builtin_amdgcn_readlane(e_hi, (g_ & 7) * 8 + u);                  \
        (VQ)[u] = *(const u32x4*)(V8 + (size_t)e * 1024 + lane * 16);                                \
      }                                                                                              \
      __builtin_amdgcn_sched_barrier(0);                                                             \
    }
#define V_CONSUME(VQ, G)                                                                            \
    {                                                                                                \
      const int g_ = (G);                                                                            \
      _Pragma("unroll") for (int u = 0; u < 8; ++u) {                                                \
        const float a = __int_as_float((g_ < 8) ? __builtin_amdgcn_readlane(a_lo, (g_ & 7) * 8 + u)  \
                                                : __builtin_amdgcn_readlane(a_hi, (g_ & 7) * 8 + u)); \
        _Pragma("unroll") for (int i = 0; i < 4; ++i) {                                              \
          f32x2_t lo = __builtin_amdgcn_cvt_pk_f32_fp8((int)(VQ)[u][i], false);                      \
          f32x2_t hi = __builtin_amdgcn_cvt_pk_f32_fp8((int)(VQ)[u][i], true);                       \
          out[4 * i] += a * lo.x; out[4 * i + 1] += a * lo.y; out[4 * i + 2] += a * hi.x; out[4 * i + 3] += a * hi.y; \
        }                                                                                            \
      }                                                                                              \
    }
    V_ISSUE(vqa, 0)
#pragma unroll 1
    for (int g = 0; g < 16; g += 2) {
      V_ISSUE(vqb, g + 1)
      V_CONSUME(vqa, g)
      if (g + 2 < 16) V_ISSUE(vqa, g + 2)
      V_CONSUME(vqb, g + 1)
    }
#undef V_ISSUE
#undef V_CONSUME
    float* orow = p.out + tok * 1024 + lane * 4;
    float4 y[4];
    float ss = 0.f;
#pragma unroll
    for (int i = 0; i < 4; ++i) {
      y[i] = *(const float4*)(orow + 256 * i);
      y[i].x += out[4 * i]; y[i].y += out[4 * i + 1]; y[i].z += out[4 * i + 2]; y[i].w += out[4 * i + 3];
      ss += y[i].x * y[i].x + y[i].y * y[i].y + y[i].z * y[i].z + y[i].w * y[i].w;
    }
    ss = wave_sum(ss);
    const float r = rsqrtf(ss * (1.f / 1024.f) + 1e-6f);
#pragma unroll
    for (int i = 0; i < 4; ++i) {
      float4 g = *(const float4*)(p.g_final + 256 * i + lane * 4);
      y[i].x *= r * g.x; y[i].y *= r * g.y; y[i].z *= r * g.z; y[i].w *= r * g.w;
      *(float4*)(orow + 256 * i) = y[i];
    }
  }
}

template <bool STORE>
DI void phase_peer(const Params& p, char* smem) {
  for (int it = vb_id(); it < 512; it += vb_n()) peer_item<STORE>(p, it, smem);
}
DI void phase_peer_v(const Params& p) {
  for (int it = vb_id(); it < 512; it += vb_n()) peer_item_v(p, it);
}

__global__ void __launch_bounds__(512) fwd_megakernel(Params p) {
  extern __shared__ __attribute__((aligned(16))) char smem[];
  cg::grid_group grid = cg::this_grid();
  __shared__ uint4 xb_words;
  if (threadIdx.x == 0) {
    xb_words = make_uint4(0u, 0u, 0u, 0u);
    hsync_impl(true);
  }
  __syncthreads();
  if (p.ws == nullptr) grid.sync();
  XcdBarrier xb = xcd_barrier_post((unsigned*)(p.ws + WS_BAR), (volatile LAS unsigned*)&xb_words);
  char* hsm = smem + half_id() * HALF_LDS;
  phase_prep(p, hsm, 0, vb_id());
  xcd_barrier(xb);
  phase_inproj(p, smem);
  xcd_barrier(xb);
  phase_compress(p, hsm);
  phase_prep(p, hsm, 1, (vb_id() + vb_n() - 128) % vb_n());
  xcd_barrier(xb);
  phase_mix(p, hsm);
  xcd_barrier(xb);
  phase_merge(p, smem);
  xcd_barrier(xb);
  phase_wo(p, smem);
  xcd_barrier(xb);
  phase_norm2(p);
  xcd_barrier(xb);
  phase_pq(p, smem);
  xcd_barrier(xb);
  phase_peer<true>(p, hsm);
  xcd_barrier(xb);
  phase_peer_v(p);
}

extern "C" void kernel_launch(void* const* d_in, const int* in_sizes, int n_in, void* d_out, int out_size, void* d_ws,
                              size_t ws_size, hipStream_t stream) {
  static int grid_blocks = 0;
  if (!grid_blocks) {
    int dev = 0, cus = 0, per_cu = 0;
    hipGetDevice(&dev);
    hipDeviceGetAttribute(&cus, hipDeviceAttributeMultiprocessorCount, dev);
    hipFuncSetAttribute((const void*)fwd_megakernel, hipFuncAttributeMaxDynamicSharedMemorySize, DYN_LDS);
    hipOccupancyMaxActiveBlocksPerMultiprocessor(&per_cu, fwd_megakernel, 512, DYN_LDS);
    if (per_cu > 1) per_cu = 1;
    if (per_cu < 1) per_cu = 1;
    grid_blocks = cus * per_cu;
  }
  Params p{};
  const float** pf = (const float**)&p;
  for (int i = 0; i < 22; ++i) pf[i] = (const float*)d_in[i];
  p.out = (float*)d_out;
  p.ws = (char*)d_ws;
  hipMemsetAsync((char*)d_ws + WS_BAR, 0, 3456 * 4, stream);
  void* args[] = {&p};
  hipError_t e = hipLaunchCooperativeKernel((void*)fwd_megakernel, dim3(grid_blocks), dim3(512), args, DYN_LDS, stream);
  if (e != hipSuccess) fprintf(stderr, "cooperative launch failed: %s (grid %d)\n", hipGetErrorString(e), grid_blocks);
}
```

```cpp
#include <hip/hip_runtime.h>
#include <hip/hip_cooperative_groups.h>
#include <cstdio>
namespace cg = cooperative_groups;

typedef unsigned short u16;
typedef unsigned long long u64;
typedef short bf16x8 __attribute__((ext_vector_type(8)));
typedef short s16x4 __attribute__((ext_vector_type(4)));
typedef float f32x16 __attribute__((ext_vector_type(16)));
typedef float f32x2_t __attribute__((ext_vector_type(2)));
typedef unsigned u32x4 __attribute__((ext_vector_type(4)));
typedef __bf16 bf16x2_t __attribute__((ext_vector_type(2)));

#define DI __device__ __forceinline__
#define MFMA32(a, b, c) __builtin_amdgcn_mfma_f32_32x32x16_bf16((a), (b), (c), 0, 0, 0)

constexpr int T_TOK = 16384;
constexpr int SEQ = 4096;
constexpr int NIN = 4608;
constexpr int HALF_LDS = 81664;
constexpr int DYN_LDS = 2 * HALF_LDS;
constexpr float LOG2E = 1.4426950408889634f;

constexpr size_t al256(size_t x) { return (x + 255) / 256 * 256; }
constexpr size_t WS_WT_IN   = 0;
constexpr size_t WS_WT_NSA  = al256(WS_WT_IN + (size_t)NIN * 1024 * 2);
constexpr size_t WS_WT_CONV = al256(WS_WT_NSA + 1024ull * 512 * 2);
constexpr size_t WS_WT_O    = al256(WS_WT_CONV + 1024ull * 512 * 2);
constexpr size_t WS_WT_PQ   = al256(WS_WT_O + 1024ull * 1024 * 2);
constexpr size_t WS_WT_C1   = al256(WS_WT_PQ + 2048ull * 1024 * 2);
constexpr size_t WS_SUBK    = al256(WS_WT_C1 + 128ull * 2048 * 2);
constexpr size_t WS_BIAS    = al256(WS_SUBK + 262144ull * 2);
constexpr size_t WS_UBF     = al256(WS_BIAS + 128 * 4);
constexpr size_t WS_VBF     = al256(WS_UBF + 16384ull * 1024 * 2);
constexpr size_t WS_XN      = al256(WS_VBF + 16384ull * 1024 * 2);
constexpr size_t WS_Q       = al256(WS_XN + 16384ull * 1024 * 2);
constexpr size_t WS_KC      = al256(WS_Q + 16384ull * 512 * 2);
constexpr size_t WS_VC      = al256(WS_KC + 16384ull * 128 * 2);
constexpr size_t WS_KS      = al256(WS_VC + 16384ull * 128 * 2);
constexpr size_t WS_KW      = al256(WS_KS + 16384ull * 128 * 2);
constexpr size_t WS_VTS     = al256(WS_KW + 16384ull * 128 * 2);
constexpr size_t WS_VTW     = al256(WS_VTS + 16384ull * 128 * 2);
constexpr size_t WS_KCMP    = al256(WS_VTW + 16384ull * 128 * 2);
constexpr size_t WS_VCMPT   = al256(WS_KCMP + 8ull * 256 * 64 * 2);
constexpr size_t WS_NG      = al256(WS_VCMPT + 8ull * 256 * 64 * 2);
constexpr size_t WS_GLU     = al256(WS_NG + 16384ull * 32 * 4);
constexpr size_t WS_MG      = al256(WS_GLU + 16384ull * 512 * 2);
constexpr size_t WS_END     = al256(WS_MG + 16384ull * 2048 * 2);
constexpr size_t WS_SU = WS_UBF + 16384ull * 1024;
constexpr size_t WS_SV = WS_VBF + 16384ull * 1024;
constexpr size_t WS_BAR = WS_END;
constexpr size_t WS_END2 = al256(WS_BAR + 3456 * 4);
static_assert(WS_END2 <= 256ull * 1024 * 1024, "workspace too big");
static_assert(WS_VTS - WS_Q == 16384ull * 1024 * 2, "xn2 alias region");

struct Params {
  const float *x, *g_mix, *w_in, *pe_k, *pe_v, *w_k1, *w_k2, *w_v1, *w_v2, *w_nsa_out, *w_dw, *b_dw, *g_ln, *b_ln,
      *w_conv_out, *w_o, *g_ffn, *w_pq, *subk, *pu, *pv, *g_final;
  float* out;
  char* ws;
};

DI u16 f2bf(float x) {
  unsigned u = __float_as_uint(x);
  u += 0x7fffu + ((u >> 16) & 1u);
  return (u16)(u >> 16);
}
DI unsigned pack2(float a, float b) {
  f32x2_t v = {a, b};
  bf16x2_t r = __builtin_convertvector(v, bf16x2_t);
  return __builtin_bit_cast(unsigned, r);
}
DI int my_tid() { int t = threadIdx.x & 255; asm volatile("" : "+v"(t)); return t; }
DI int tid512() { int t = threadIdx.x; asm volatile("" : "+v"(t)); return t; }
DI int half_id() { return __builtin_amdgcn_readfirstlane((int)(threadIdx.x >> 8)); }
DI int vb_id() { return (int)blockIdx.x + half_id() * (int)gridDim.x; }
DI int vb_n() { return (int)gridDim.x * 2; }
DI void hsync_impl(const bool INIT) {
  __shared__ unsigned hb[4];
  if (INIT) {
    hb[0] = 0u; hb[1] = 0u; hb[2] = 0u; hb[3] = 0u;
    return;
  }
  asm volatile("s_waitcnt vmcnt(0) lgkmcnt(0)" ::: "memory");
  if ((threadIdx.x & 63) == 0) {
    const int h2 = 2 * half_id();
    const unsigned gen = __hip_atomic_load(&hb[h2 + 1], __ATOMIC_RELAXED, __HIP_MEMORY_SCOPE_WORKGROUP);
    const unsigned old = __hip_atomic_fetch_add(&hb[h2], 1u, __ATOMIC_RELAXED, __HIP_MEMORY_SCOPE_WORKGROUP);
    if (old == 3u) {
      __hip_atomic_store(&hb[h2], 0u, __ATOMIC_RELAXED, __HIP_MEMORY_SCOPE_WORKGROUP);
      asm volatile("s_waitcnt vmcnt(0) lgkmcnt(0)" ::: "memory");
      __hip_atomic_fetch_add(&hb[h2 + 1], 1u, __ATOMIC_RELAXED, __HIP_MEMORY_SCOPE_WORKGROUP);
    } else {
      while (__hip_atomic_load(&hb[h2 + 1], __ATOMIC_RELAXED, __HIP_MEMORY_SCOPE_WORKGROUP) == gen) __builtin_amdgcn_s_sleep(1);
    }
  }
  asm volatile("s_waitcnt vmcnt(0) lgkmcnt(0)" ::: "memory");
}
DI void hsync() { hsync_impl(false); }
DI float bflo(unsigned u) { return __uint_as_float(u << 16); }
DI float bfhi(unsigned u) { return __uint_as_float(u & 0xffff0000u); }
DI float wave_sum(float v) {
#pragma unroll
  for (int o = 32; o > 0; o >>= 1) v += __shfl_xor(v, o);
  return v;
}
DI float sigmoidf_(float x) { return 1.f / (1.f + __expf(-x)); }
DI float gelu_exact(float x) { return 0.5f * x * (1.f + erff(x * 0.7071067811865476f)); }
DI float fexp2(float x) { return __builtin_amdgcn_exp2f(x); }
DI int swap23(int t) { return (t & ~12) | ((t & 4) << 1) | ((t & 8) >> 1); }
DI int crow(int i, int hh) { return (i & 3) + 8 * (i >> 2) + 4 * hh; }
DI unsigned f2ord(float f) {
  unsigned u = __float_as_uint(f);
  return (u & 0x80000000u) ? ~u : (u | 0x80000000u);
}
DI float ord2f(unsigned u) { return __uint_as_float((u & 0x80000000u) ? (u ^ 0x80000000u) : ~u); }

#define XB_TMO      128
#define XB_XCNT(j)  (256  + 64 * (j))
#define XB_XSUB(j)  (1280 + 64 * (j))
#define XB_XGEN(j)  (2304 + 64 * (j))
#define XB_TOP      3328
#define XB_TOPGEN   3392
#define XCD_BAR_WORDS 3456
#define XB_SPIN_CAP (1u << 18)
#define LAS __attribute__((address_space(3)))

__device__ __forceinline__ unsigned xb_ld(unsigned* p)              { return __hip_atomic_load(p, __ATOMIC_RELAXED, __HIP_MEMORY_SCOPE_AGENT); }
__device__ __forceinline__ unsigned xb_add(unsigned* p, unsigned v) { return __hip_atomic_fetch_add(p, v, __ATOMIC_RELAXED, __HIP_MEMORY_SCOPE_AGENT); }
__device__ __forceinline__ unsigned xb_xcc_id() { return (unsigned)__builtin_amdgcn_s_getreg((3 << 11) | 20) & 0xFu; }
#define XB_SPIN(cond, bar) do { unsigned _sp = 0; while (cond) { __builtin_amdgcn_s_sleep(1); \
    if ((++_sp & 255u) == 0u) { if (xb_ld(&(bar)[XB_TMO])) break; if (_sp > XB_SPIN_CAP) { atomicAdd(&(bar)[XB_TMO], 1u); break; } } } } while (0)

struct XcdBarrier {
    unsigned* bar; unsigned x;
    volatile LAS unsigned* st;
};

__device__ __forceinline__ XcdBarrier xcd_barrier_post(unsigned* bar, volatile LAS unsigned* st) {
    XcdBarrier b; b.bar = bar; b.x = xb_xcc_id(); b.st = st;
    if (threadIdx.x == 0) (void)xb_add(&bar[XB_XCNT(b.x)], 1u);
    return b;
}
__device__ __forceinline__ void xcd_barrier_complete(unsigned* bar, unsigned x, unsigned& nloc, unsigned& nx) {
    const unsigned G = gridDim.x * gridDim.y * gridDim.z;
    unsigned sum, cnt, mine, sp = 0u;
    for (;;) {
        sum = 0u; cnt = 0u; mine = 0u;
#pragma unroll
        for (unsigned j = 0; j < 16; ++j) { const unsigned c = xb_ld(&bar[XB_XCNT(j)]); sum += c; cnt += (c > 0u) ? 1u : 0u; mine = (j == x) ? c : mine; }
        if (sum == G) break;
        __builtin_amdgcn_s_sleep(1);
        if ((++sp & 255u) == 0u) { if (xb_ld(&bar[XB_TMO])) break; if (sp > XB_SPIN_CAP) { atomicAdd(&bar[XB_TMO], 1u); break; } }
    }
    nloc = mine > 0u ? mine : 1u; nx = cnt > 0u ? cnt : 1u;
}

__device__ __forceinline__ void xcd_barrier(const XcdBarrier& b) {
    asm volatile("s_waitcnt vmcnt(0)" ::: "memory");
    __syncthreads();
    if (threadIdx.x == 0) {
        unsigned* bar = b.bar;
        __builtin_amdgcn_s_waitcnt(0);
        unsigned nloc = b.st[0], nx = b.st[1];
        if (nloc == 0u) { xcd_barrier_complete(bar, b.x, nloc, nx); b.st[0] = nloc; b.st[1] = nx; }
        const unsigned old = xb_add(&bar[XB_XSUB(b.x)], 1u);
        const unsigned gen = old / nloc;
        if (old + 1u == (gen + 1u) * nloc) {
            __builtin_amdgcn_fence(__ATOMIC_RELEASE, "agent");
            asm volatile("s_waitcnt vmcnt(0)" ::: "memory");
            const unsigned og = xb_add(&bar[XB_TOP], 1u);
            const unsigned tg = og / nx;
            if (og + 1u == (tg + 1u) * nx) xb_add(&bar[XB_TOPGEN], 1u);
            else XB_SPIN(xb_ld(&bar[XB_TOPGEN]) == tg, bar);
            __builtin_amdgcn_fence(__ATOMIC_ACQUIRE, "agent");
            xb_add(&bar[XB_XGEN(b.x)], 1u);
            asm volatile("s_waitcnt vmcnt(0)" ::: "memory");
        } else {
            XB_SPIN(xb_ld(&bar[XB_XGEN(b.x)]) == gen, bar);
            __builtin_amdgcn_fence(__ATOMIC_ACQUIRE, "agent");
            asm volatile("s_waitcnt vmcnt(0)" ::: "memory");
        }
    }
    __syncthreads();
}


DI int inproj_colmap(int p) {
  if (p < 1280) return p;
  if (p < 2304) {
    int j = p - 1280;
    int blk = j >> 7, w = j & 127;
    return 1304 + (w < 64 ? blk * 64 + w : 512 + blk * 64 + (w - 64));
  }
  if (p < 4352) return 2328 + (p - 2304);
  if (p < 4376) return 1280 + (p - 4352);
  return -1;
}

template <bool MAPPED>
DI void transpose_tile(const float* __restrict__ W, int K, int N, u16* __restrict__ Wt, int kt, int nt, char* smem) {
  float* s = (float*)smem;
  const int tid = my_tid();
  hsync();
#pragma unroll 4
  for (int i = 0; i < 16; ++i) {
    int idx = tid + 256 * i;
    int kk = idx >> 6, pp = idx & 63;
    int pcol = nt * 64 + pp;
    int oc = MAPPED ? inproj_colmap(pcol) : pcol;
    float v = 0.f;
    if (oc >= 0) v = W[(size_t)(kt * 64 + kk) * N + oc];
    s[kk * 65 + pp] = v;
  }
  hsync();
#pragma unroll 4
  for (int i = 0; i < 16; ++i) {
    int idx = tid + 256 * i;
    int pp = idx >> 6, kk = idx & 63;
    Wt[(size_t)(nt * 64 + pp) * K + kt * 64 + kk] = f2bf(s[kk * 65 + pp]);
  }
}

DI void rms_row(const float* __restrict__ xr, const float* __restrict__ g, u16* __restrict__ dst, int lane) {
  float4 v[4];
  float ss = 0.f;
#pragma unroll
  for (int i = 0; i < 4; ++i) {
    v[i] = *(const float4*)(xr + lane * 4 + 256 * i);
    ss += v[i].x * v[i].x + v[i].y * v[i].y + v[i].z * v[i].z + v[i].w * v[i].w;
  }
  ss = wave_sum(ss);
  float r = rsqrtf(ss * (1.f / 1024.f) + 1e-6f);
#pragma unroll
  for (int i = 0; i < 4; ++i) {
    float4 gg = *(const float4*)(g + lane * 4 + 256 * i);
    uint2 o;
    o.x = pack2(v[i].x * r * gg.x, v[i].y * r * gg.y);
    o.y = pack2(v[i].z * r * gg.z, v[i].w * r * gg.w);
    *(uint2*)(dst + lane * 4 + 256 * i) = o;
  }
}

DI void convert_chunk(const float* __restrict__ src, u16* __restrict__ dst, int item) {
  const int tid = my_tid();
#pragma unroll
  for (int i = 0; i < 4; ++i) {
    size_t idx = (size_t)item * 8192 + i * 2048 + tid * 8;
    float4 a = *(const float4*)(src + idx);
    float4 b = *(const float4*)(src + idx + 4);
    uint4 o;
    o.x = pack2(a.x, a.y); o.y = pack2(a.z, a.w); o.z = pack2(b.x, b.y); o.w = pack2(b.z, b.w);
    *(uint4*)(dst + idx) = o;
  }
}

template <int NR>
DI void fp8_rows(const float* __restrict__ src, unsigned char* __restrict__ dst, float* __restrict__ scale_out, int lane) {
  float4 v[NR][4];
#pragma unroll
  for (int r = 0; r < NR; ++r)
#pragma unroll
    for (int i = 0; i < 4; ++i) v[r][i] = *(const float4*)(src + (size_t)r * 1024 + 256 * i + lane * 4);
#pragma unroll
  for (int r = 0; r < NR; ++r) {
    float amax = 0.f;
#pragma unroll
    for (int i = 0; i < 4; ++i)
      amax = fmaxf(amax, fmaxf(fmaxf(fabsf(v[r][i].x), fabsf(v[r][i].y)), fmaxf(fabsf(v[r][i].z), fabsf(v[r][i].w))));
#pragma unroll
    for (int o = 32; o > 0; o >>= 1) amax = fmaxf(amax, __shfl_xor(amax, o));
    const float scale = amax > 0.f ? amax * (1.f / 440.f) : 1.f;
    const float inv = 1.f / scale;
    u32x4 w;
#pragma unroll
    for (int i = 0; i < 4; ++i) {
      int t = 0;
      t = __builtin_amdgcn_cvt_pk_fp8_f32(v[r][i].x * inv, v[r][i].y * inv, t, false);
      t = __builtin_amdgcn_cvt_pk_fp8_f32(v[r][i].z * inv, v[r][i].w * inv, t, true);
      w[i] = (unsigned)t;
    }
    *(u32x4*)(dst + (size_t)r * 1024 + lane * 16) = w;
    if (lane == 0) scale_out[r] = scale;
  }
}

template <int NR>
DI void rms_rows(const float* __restrict__ xr, const float* __restrict__ g, u16* __restrict__ dst, int lane) {
  float4 v[NR][4];
#pragma unroll
  for (int r = 0; r < NR; ++r)
#pragma unroll
    for (int i = 0; i < 4; ++i) v[r][i] = *(const float4*)(xr + (size_t)r * 1024 + lane * 4 + 256 * i);
  float4 gg[4];
#pragma unroll
  for (int i = 0; i < 4; ++i) gg[i] = *(const float4*)(g + lane * 4 + 256 * i);
#pragma unroll
  for (int r = 0; r < NR; ++r) {
    float ss = 0.f;
#pragma unroll
    for (int i = 0; i < 4; ++i) ss += v[r][i].x * v[r][i].x + v[r][i].y * v[r][i].y + v[r][i].z * v[r][i].z + v[r][i].w * v[r][i].w;
    ss = wave_sum(ss);
    const float rr = rsqrtf(ss * (1.f / 1024.f) + 1e-6f);
#pragma unroll
    for (int i = 0; i < 4; ++i) {
      uint2 o;
      o.x = pack2(v[r][i].x * rr * gg[i].x, v[r][i].y * rr * gg[i].y);
      o.y = pack2(v[r][i].z * rr * gg[i].z, v[r][i].w * rr * gg[i].w);
      *(uint2*)(dst + (size_t)r * 1024 + lane * 4 + 256 * i) = o;
    }
  }
}

DI void phase_prep(const Params& p, char* smem, int part, int vb) {
  char* ws = p.ws;
  const int tid = my_tid(), lane = tid & 63, wave = tid >> 6;
  if (part == 0) {
    const int NITEMS = 1024 + 1152 + 64;
    for (int it0 = vb; it0 < NITEMS; it0 += vb_n()) {
      int it = it0;
      if (it < 1024) {
        int row = it * 16 + wave * 4;
        rms_rows<4>(p.x + (size_t)row * 1024, p.g_mix, (u16*)(ws + WS_XN) + (size_t)row * 1024, lane);
        continue;
      }
      it -= 1024;
      if (it < 1152) { transpose_tile<true>(p.w_in, 1024, 4376, (u16*)(ws + WS_WT_IN), it / 72, it % 72, smem); continue; }
      it -= 1152;
      {
        int kv = it >> 5, kt = it & 31;
        transpose_tile<false>(kv ? p.w_v1 : p.w_k1, 2048, 64, (u16*)(ws + WS_WT_C1) + (size_t)kv * 64 * 2048, kt, 0, smem);
      }
    }
  } else {
    const int NITEMS = 1024 + 1024 + 128 + 128 + 256 + 512 + 32;
    for (int it0 = vb; it0 < NITEMS; it0 += vb_n()) {
      int it = it0;
      if (it < 1024) {
        int row = it * 16 + wave * 4;
        fp8_rows<4>(p.pu + (size_t)row * 1024, (unsigned char*)(ws + WS_UBF) + (size_t)row * 1024, (float*)(ws + WS_SU) + row, lane);
        continue;
      }
      it -= 1024;
      if (it < 1024) {
        int row = it * 16 + wave * 4;
        fp8_rows<4>(p.pv + (size_t)row * 1024, (unsigned char*)(ws + WS_VBF) + (size_t)row * 1024, (float*)(ws + WS_SV) + row, lane);
        continue;
      }
      it -= 1024;
      if (it < 128) { transpose_tile<false>(p.w_nsa_out, 512, 1024, (u16*)(ws + WS_WT_NSA), it / 16, it % 16, smem); continue; }
      it -= 128;
      if (it < 128) { transpose_tile<false>(p.w_conv_out, 512, 1024, (u16*)(ws + WS_WT_CONV), it / 16, it % 16, smem); continue; }
      it -= 128;
      if (it < 256) { transpose_tile<false>(p.w_o, 1024, 1024, (u16*)(ws + WS_WT_O), it / 16, it % 16, smem); continue; }
      it -= 256;
      if (it < 512) { transpose_tile<false>(p.w_pq, 1024, 2048, (u16*)(ws + WS_WT_PQ), it / 32, it % 32, smem); continue; }
      it -= 512;
      convert_chunk(p.subk, (u16*)(ws + WS_SUBK), it);
    }
  }
}

template <int WM, class AF, class BF>
DI void gemm512(f32x16 (&acc)[WM][2], AF arow, int a_kstep, BF brow, int b_kstep, int KT, char* smem) {
  constexpr int AM = WM * 64;
  constexpr int NA = AM / 64;
  const int tid = tid512(), lane = tid & 63, wave = tid >> 6;
  const int wm = wave >> 2, wn = wave & 3, lr = lane & 31, hh = lane >> 5;
  const u16* ap[NA];
  const u16* bp[4];
  int soa[NA], sob[4];
#pragma unroll
  for (int i = 0; i < NA; ++i) {
    int c = tid + 512 * i;
    int row = c >> 3, kc = (c & 7) * 8;
    ap[i] = arow(row) + kc;
    soa[i] = row * 72 + kc;
  }
#pragma unroll
  for (int i = 0; i < 4; ++i) {
    int c = tid + 512 * i;
    int row = c >> 3, kc = (c & 7) * 8;
    bp[i] = brow(row) + kc;
    sob[i] = row * 72 + kc;
  }
  u32x4 ra0[NA], rb0[4], ra1[NA], rb1[4];
#pragma unroll
  for (int i = 0; i < NA; ++i) ra0[i] = *(const u32x4*)ap[i];
#pragma unroll
  for (int i = 0; i < 4; ++i) rb0[i] = *(const u32x4*)bp[i];
  {
    const int s1 = (KT > 1) ? 1 : 0;
#pragma unroll
    for (int i = 0; i < NA; ++i) ra1[i] = *(const u32x4*)(ap[i] + s1 * a_kstep);
#pragma unroll
    for (int i = 0; i < 4; ++i) rb1[i] = *(const u32x4*)(bp[i] + s1 * b_kstep);
  }
  u16* A0 = (u16*)smem;
  u16* B0 = A0 + AM * 72;
  u16* A1 = B0 + 256 * 72;
  u16* B1 = A1 + AM * 72;
  __syncthreads();
#pragma unroll
  for (int i = 0; i < NA; ++i) *(u32x4*)(A0 + soa[i]) = ra0[i];
#pragma unroll
  for (int i = 0; i < 4; ++i) *(u32x4*)(B0 + sob[i]) = rb0[i];
  __syncthreads();
  const int fa = (wm * WM * 32 + lr) * 72 + hh * 8, fb = (wn * 64 + lr) * 72 + hh * 8;
#define GEMM_STEP(AS, BS, AD, BD, RLA, RLB, RSA, RSB, SNEXT)                                      \
  {                                                                                              \
    const int sn = (SNEXT) < KT ? (SNEXT) : KT - 1;                                              \
    _Pragma("unroll") for (int i = 0; i < NA; ++i) RLA[i] = *(const u32x4*)(ap[i] + sn * a_kstep); \
    _Pragma("unroll") for (int i = 0; i < 4; ++i) RLB[i] = *(const u32x4*)(bp[i] + sn * b_kstep);  \
    _Pragma("unroll") for (int ks = 0; ks < 4; ++ks) {                                           \
      bf16x8 b0 = *(const bf16x8*)((BS) + fb + ks * 16);                                         \
      bf16x8 b1 = *(const bf16x8*)((BS) + fb + 32 * 72 + ks * 16);                               \
      _Pragma("unroll") for (int i = 0; i < WM; ++i) {                                           \
        bf16x8 a = *(const bf16x8*)((AS) + fa + i * 32 * 72 + ks * 16);                          \
        acc[i][0] = MFMA32(a, b0, acc[i][0]);                                                    \
        acc[i][1] = MFMA32(a, b1, acc[i][1]);                                                    \
      }                                                                                          \
    }                                                                                            \
    _Pragma("unroll") for (int i = 0; i < NA; ++i) *(u32x4*)((AD) + soa[i]) = RSA[i];            \
    _Pragma("unroll") for (int i = 0; i < 4; ++i) *(u32x4*)((BD) + sob[i]) = RSB[i];             \
    __syncthreads();                                                                             \
  }
#pragma unroll 1
  for (int kt = 0; kt < KT; kt += 2) {
    GEMM_STEP(A0, B0, A1, B1, ra0, rb0, ra1, rb1, kt + 2)
    if (kt + 1 < KT) GEMM_STEP(A1, B1, A0, B0, ra1, rb1, ra0, rb0, kt + 3)
  }
#undef GEMM_STEP
}

template <int WM>
DI void zero_acc(f32x16 (&acc)[WM][2]) {
#pragma unroll
  for (int i = 0; i < WM; ++i)
#pragma unroll
    for (int j = 0; j < 2; ++j)
#pragma unroll
      for (int e = 0; e < 16; ++e) acc[i][j][e] = 0.f;
}

DI bool xcd_tile(int k, int NT, int MPX, int& mt, int& nt) {
  const int x = blockIdx.x & 7, lb = blockIdx.x >> 3, nlb = gridDim.x >> 3;
  const int r = lb + nlb * k;
  if (r >= MPX * NT) return false;
  nt = r / MPX;
  mt = x * MPX + (r % MPX);
  return true;
}

template <int WM>
DI void inproj_tile(const Params& p, char* smem, const int m0, const int n0) {
  char* ws = p.ws;
  const u16* XN = (const u16*)(ws + WS_XN);
  const u16* WT = (const u16*)(ws + WS_WT_IN);
  u16* Q = (u16*)(ws + WS_Q);
  u16* KC = (u16*)(ws + WS_KC);
  u16* VC = (u16*)(ws + WS_VC);
  u16* KS = (u16*)(ws + WS_KS);
  u16* KW = (u16*)(ws + WS_KW);
  u16* VTS = (u16*)(ws + WS_VTS);
  u16* VTW = (u16*)(ws + WS_VTW);
  float* NG = (float*)(ws + WS_NG);
  u16* GLU = (u16*)(ws + WS_GLU);
  u16* MG = (u16*)(ws + WS_MG);
  const int tid = tid512(), lane = tid & 63, wave = tid >> 6;
  const int wm = wave >> 2, wn = wave & 3, lr = lane & 31, hh = lane >> 5;
  f32x16 acc[WM][2];
  zero_acc<WM>(acc);
  gemm512<WM>(acc, [&](int r) { return WT + (size_t)(n0 + r) * 1024; }, 64,
              [&](int r) { return XN + (size_t)(m0 + r) * 1024; }, 64, 16, smem);
  const int fw = n0 + wm * (WM * 32);
  const int tb = m0 + wn * 64 + lr;
  if (fw < 512) {
#pragma unroll
    for (int i = 0; i < WM; ++i)
#pragma unroll
      for (int j = 0; j < 2; ++j)
#pragma unroll
        for (int q4 = 0; q4 < 4; ++q4) {
          const int f = fw + i * 32 + q4 * 8 + hh * 4;
          const size_t t = tb + j * 32;
          const float sc = 0.125f * LOG2E;
          uint2 o;
          o.x = pack2(acc[i][j][q4 * 4 + 0] * sc, acc[i][j][q4 * 4 + 1] * sc);
          o.y = pack2(acc[i][j][q4 * 4 + 2] * sc, acc[i][j][q4 * 4 + 3] * sc);
          *(uint2*)(Q + t * 512 + f) = o;
        }
  } else if (fw < 1280) {
    const int sec = (fw - 512) >> 7;
    const int c0 = (fw - 512) & 127;
    if (sec == 3 || sec == 5) {
      u16* VT = (sec == 3) ? VTS : VTW;
#pragma unroll
      for (int i = 0; i < WM; ++i)
#pragma unroll
        for (int j = 0; j < 2; ++j)
#pragma unroll
          for (int e = 0; e < 16; ++e) {
            const int c = c0 + i * 32 + crow(e, hh);
            const int tt = tb + j * 32;
            const int b = tt >> 12, t = tt & 4095;
            VT[((size_t)(b * 128 + c)) * 4096 + swap23(t)] = f2bf(acc[i][j][e]);
          }
    } else {
      u16* dst = (sec == 0) ? KC : (sec == 1) ? VC : (sec == 2) ? KS : KW;
#pragma unroll
      for (int i = 0; i < WM; ++i)
#pragma unroll
        for (int j = 0; j < 2; ++j)
#pragma unroll
          for (int q4 = 0; q4 < 4; ++q4) {
            const int c = c0 + i * 32 + q4 * 8 + hh * 4;
            const size_t t = tb + j * 32;
            uint2 o;
            o.x = pack2(acc[i][j][q4 * 4 + 0], acc[i][j][q4 * 4 + 1]);
            o.y = pack2(acc[i][j][q4 * 4 + 2], acc[i][j][q4 * 4 + 3]);
            *(uint2*)(dst + t * 128 + c) = o;
          }
    }
  } else if (fw < 2304) {
    if (WM == 4) {
      const int blk = (fw - 1280) >> 7;
#pragma unroll
      for (int i = 0; i < 2; ++i)
#pragma unroll
        for (int j = 0; j < 2; ++j)
#pragma unroll
          for (int q4 = 0; q4 < 4; ++q4) {
            const int ch = blk * 64 + i * 32 + q4 * 8 + hh * 4;
            const size_t t = tb + j * 32;
            float u[4];
#pragma unroll
            for (int z = 0; z < 4; ++z) u[z] = acc[i][j][q4 * 4 + z] * sigmoidf_(acc[(i + 2) & (WM - 1)][j][q4 * 4 + z]);
            uint2 o;
            o.x = pack2(u[0], u[1]);
            o.y = pack2(u[2], u[3]);
            *(uint2*)(GLU + t * 512 + ch) = o;
          }
    }
  } else if (fw < 4352) {
#pragma unroll
    for (int i = 0; i < WM; ++i)
#pragma unroll
      for (int j = 0; j < 2; ++j)
#pragma unroll
        for (int q4 = 0; q4 < 4; ++q4) {
          const int f = fw - 2304 + i * 32 + q4 * 8 + hh * 4;
          const size_t t = tb + j * 32;
          uint2 o;
          o.x = pack2(sigmoidf_(acc[i][j][q4 * 4 + 0]), sigmoidf_(acc[i][j][q4 * 4 + 1]));
          o.y = pack2(sigmoidf_(acc[i][j][q4 * 4 + 2]), sigmoidf_(acc[i][j][q4 * 4 + 3]));
          *(uint2*)(MG + t * 2048 + f) = o;
        }
  } else if (fw == 4352) {
#pragma unroll
    for (int j = 0; j < 2; ++j)
#pragma unroll
      for (int q4 = 0; q4 < 3; ++q4) {
        const int f = q4 * 8 + hh * 4;
        const size_t t = tb + j * 32;
        float4 o;
        o.x = sigmoidf_(acc[0][j][q4 * 4 + 0]); o.y = sigmoidf_(acc[0][j][q4 * 4 + 1]);
        o.z = sigmoidf_(acc[0][j][q4 * 4 + 2]); o.w = sigmoidf_(acc[0][j][q4 * 4 + 3]);
        *(float4*)(NG + t * 32 + f) = o;
      }
  }
}

DI void phase_inproj(const Params& p, char* smem) {
  const int NT = NIN / 256;
  if (gridDim.x == 256) {
    const int x = blockIdx.x & 7, lb = blockIdx.x >> 3;
#pragma unroll 1
    for (int k = 0; k < 4; ++k) {
      const int r = lb + 32 * k;
      inproj_tile<4>(p, smem, (x * 8 + (r & 7)) * 256, (r >> 3) * 256);
    }
    const int r2 = 128 + (lb >> 1);
    inproj_tile<2>(p, smem, (x * 8 + (r2 & 7)) * 256, (r2 >> 3) * 256 + (lb & 1) * 128);
  } else {
    for (int kk = 0;; ++kk) {
      int mt, nt;
      if (!xcd_tile(kk, NT, 8, mt, nt)) break;
      inproj_tile<4>(p, smem, mt * 256, nt * 256);
    }
  }
}

DI void phase_compress(const Params& p, char* smem) {
  char* ws = p.ws;
  const u16* KC = (const u16*)(ws + WS_KC);
  const u16* VC = (const u16*)(ws + WS_VC);
  const u16* WT = (const u16*)(ws + WS_WT_C1);
  u16* KCMP = (u16*)(ws + WS_KCMP);
  u16* VCMPT = (u16*)(ws + WS_VCMPT);
  float* Hs = (float*)smem;
  const int tid = my_tid(), lane = tid & 63, wave = tid >> 6;
  const int lr = lane & 31, hh = lane >> 5;
  for (int it = vb_id(); it < 128; it += vb_n()) {
    const int kv = it & 1, mt = it >> 1;
    const u16* SRC = kv ? VC : KC;
    const float* pe = kv ? p.pe_v : p.pe_k;
    int mi = mt * 32 + lr;
    int bg = mi >> 8, n = mi & 255;
    if (n > 254) n = 254;
    const u16* arow = SRC + ((size_t)((bg >> 1) * 4096 + 16 * n)) * 128 + (bg & 1) * 64 + hh * 8;
    const u16* brow0 = WT + ((size_t)(kv * 64 + lr)) * 2048 + hh * 8;
    const u16* brow1 = brow0 + (size_t)32 * 2048;
    f32x16 acc0, acc1;
#pragma unroll
    for (int e = 0; e < 16; ++e) { acc0[e] = 0.f; acc1[e] = 0.f; }
#pragma unroll 4
    for (int sI = 0; sI < 32; ++sI) {
      const int s_ = wave * 32 + sI;
      const int l = s_ >> 2, d0 = (s_ & 3) * 16;
      u32x4 ar = *(const u32x4*)(arow + l * 128 + d0);
      float4 p0 = *(const float4*)(pe + l * 64 + d0 + hh * 8);
      float4 p1 = *(const float4*)(pe + l * 64 + d0 + hh * 8 + 4);
      bf16x8 b0 = *(const bf16x8*)(brow0 + s_ * 16);
      bf16x8 b1 = *(const bf16x8*)(brow1 + s_ * 16);
      u32x4 aw;
      aw[0] = pack2(bflo(ar[0]) + p0.x, bfhi(ar[0]) + p0.y);
      aw[1] = pack2(bflo(ar[1]) + p0.z, bfhi(ar[1]) + p0.w);
      aw[2] = pack2(bflo(ar[2]) + p1.x, bfhi(ar[2]) + p1.y);
      aw[3] = pack2(bflo(ar[3]) + p1.z, bfhi(ar[3]) + p1.w);
      bf16x8 a = __builtin_bit_cast(bf16x8, aw);
      acc0 = MFMA32(a, b0, acc0);
      acc1 = MFMA32(a, b1, acc1);
    }
    hsync();
#pragma unroll
    for (int e = 0; e < 16; ++e) {
      Hs[(wave * 32 + crow(e, hh)) * 65 + lr] = acc0[e];
      Hs[(wave * 32 + crow(e, hh)) * 65 + 32 + lr] = acc1[e];
    }
    hsync();
    const int row = tid >> 3, c0 = (tid & 7) * 8;
#pragma unroll
    for (int c = 0; c < 8; ++c) {
      float h = Hs[row * 65 + c0 + c] + Hs[(32 + row) * 65 + c0 + c] + Hs[(64 + row) * 65 + c0 + c] + Hs[(96 + row) * 65 + c0 + c];
      Hs[row * 65 + c0 + c] = gelu_exact(h);
    }
    hsync();
    {
      const float* w2 = kv ? p.w_v2 : p.w_k2;
      float o[8];
#pragma unroll
      for (int c = 0; c < 8; ++c) o[c] = 0.f;
#pragma unroll 8
      for (int i = 0; i < 64; ++i) {
        float hv = Hs[row * 65 + i];
        float4 wa = *(const float4*)(w2 + i * 64 + c0);
        float4 wb = *(const float4*)(w2 + i * 64 + c0 + 4);
        o[0] += hv * wa.x; o[1] += hv * wa.y; o[2] += hv * wa.z; o[3] += hv * wa.w;
        o[4] += hv * wb.x; o[5] += hv * wb.y; o[6] += hv * wb.z; o[7] += hv * wb.w;
      }
      int mi2 = mt * 32 + row;
      int bg2 = mi2 >> 8, n2 = mi2 & 255;
      if (n2 == 255) {
#pragma unroll
        for (int c = 0; c < 8; ++c) o[c] = 0.f;
      }
      if (kv == 0) {
        u32x4 w;
        w[0] = pack2(o[0], o[1]); w[1] = pack2(o[2], o[3]); w[2] = pack2(o[4], o[5]); w[3] = pack2(o[6], o[7]);
        *(u32x4*)(KCMP + ((size_t)(bg2 * 256 + n2)) * 64 + c0) = w;
      } else {
#pragma unroll
        for (int c = 0; c < 8; ++c) VCMPT[((size_t)(bg2 * 64 + c0 + c)) * 256 + swap23(n2)] = f2bf(o[c]);
      }
    }
    hsync();
  }
}

template <int KSTRIDE, bool WIN, int MASK, int MODE>
DI void attend_tile(const u16* Ks, const u16* Vts, const bf16x8 (&qf)[4], f32x16 (&O)[2], float& m, float& l, int dbase,
                    float slope2, bool lanesel, float invl, unsigned* imp_row, int mbase, int lr, int hh) {
  f32x16 s[2];
#pragma unroll
  for (int kt = 0; kt < 2; ++kt) {
#pragma unroll
    for (int e = 0; e < 16; ++e) s[kt][e] = 0.f;
#pragma unroll
    for (int ks = 0; ks < 4; ++ks) {
      bf16x8 a = *(const bf16x8*)(Ks + (kt * 32 + lr) * 72 + ks * 16 + hh * 8);
      s[kt] = MFMA32(a, qf[ks], s[kt]);
    }
  }
  const float fd0 = (float)(dbase - KSTRIDE * 4 * hh);
  const float ct = slope2 * fd0;
  float mx = -1e30f;
#pragma unroll
  for (int kt = 0; kt < 2; ++kt)
#pragma unroll
    for (int e = 0; e < 16; ++e) {
      const float Ke = (float)(KSTRIDE * (kt * 32 + (e & 3) + 8 * (e >> 2)));
      float v = fmaf(slope2, Ke, s[kt][e]);
      if (MASK == 1) {
        const float fd = fd0 - Ke;
        bool valid = fd >= 0.f;
        if (WIN) valid = valid && (fd < 512.f);
        valid = valid && lanesel;
        v = valid ? v : -1e30f;
      }
      s[kt][e] = v;
      mx = fmaxf(mx, v);
    }
  mx = (mx > -1e29f) ? mx - ct : -1e30f;
  mx = fmaxf(mx, __shfl_xor(mx, 32));
  if (MASK == 2) mx = lanesel ? mx : -1e30f;
  float mnew = m, alpha = 1.f;
  if (MODE != 2) {
    mnew = fmaxf(m, mx);
    alpha = fexp2(m - mnew);
    m = mnew;
  }
  float shift = mnew + ct;
  if (MASK == 2) shift = lanesel ? shift : 1e30f;
  float rs = 0.f;
#pragma unroll
  for (int kt = 0; kt < 2; ++kt)
#pragma unroll
    for (int e = 0; e < 16; ++e) {
      float v = s[kt][e];
      float pv;
      if (MASK == 1) pv = (v > -1e29f) ? fexp2(v - shift) : 0.f;
      else pv = fexp2(v - shift);
      if (MODE == 2) pv *= invl;
      s[kt][e] = pv;
      rs += pv;
    }
  if (MODE != 2) l = l * alpha + rs;
  if (MODE == 1) return;
  if (MODE == 0) {
#pragma unroll
    for (int e = 0; e < 16; ++e) { O[0][e] *= alpha; O[1][e] *= alpha; }
  }
  if (MODE == 2) {
#pragma unroll
    for (int kt = 0; kt < 2; ++kt)
#pragma unroll
      for (int q4 = 0; q4 < 4; ++q4) {
        float qsum = s[kt][q4 * 4] + s[kt][q4 * 4 + 1] + s[kt][q4 * 4 + 2] + s[kt][q4 * 4 + 3];
        float last = s[kt][q4 * 4 + 3];
        int mi = mbase + kt * 8 + 2 * q4 + hh;
        atomicAdd(imp_row + mi, (unsigned)(qsum * 67108864.f + 0.5f));
        if (mi + 1 < 64) atomicAdd(imp_row + mi + 1, (unsigned)(last * 67108864.f + 0.5f));
      }
  }
#pragma unroll
  for (int kt = 0; kt < 2; ++kt)
#pragma unroll
    for (int sx = 0; sx < 2; ++sx) {
      unsigned pk[4];
#pragma unroll
      for (int q = 0; q < 4; ++q) pk[q] = pack2(s[kt][8 * sx + 2 * q], s[kt][8 * sx + 2 * q + 1]);
      bf16x8 pb;
      {
        u32x4 t4 = {pk[0], pk[1], pk[2], pk[3]};
        pb = __builtin_bit_cast(bf16x8, t4);
      }
#pragma unroll
      for (int dt = 0; dt < 2; ++dt) {
        bf16x8 a = *(const bf16x8*)(Vts + (dt * 32 + lr) * 72 + kt * 32 + 16 * sx + 8 * hh);
        O[dt] = MFMA32(a, pb, O[dt]);
      }
    }
}

struct KVRegs { u32x4 k[2], v[2]; };
DI void kv_issue(KVRegs& r, const u16* ksrc, int kstride, const u16* vsrc, int vstride, int tid) {
#pragma unroll
  for (int i = 0; i < 2; ++i) {
    int c = tid + 256 * i;
    int row = c >> 3, ch = (c & 7) * 8;
    r.k[i] = *(const u32x4*)(ksrc + (size_t)row * kstride + ch);
    r.v[i] = *(const u32x4*)(vsrc + (size_t)row * vstride + ch);
  }
}
DI void kv_commit(const KVRegs& r, u16* Ks, u16* Vts, int tid) {
#pragma unroll
  for (int i = 0; i < 2; ++i) {
    int c = tid + 256 * i;
    int row = c >> 3, ch = (c & 7) * 8;
    *(u32x4*)(Ks + row * 72 + ch) = r.k[i];
    *(u32x4*)(Vts + row * 72 + ch) = r.v[i];
  }
  hsync();
}

DI void attn_item(const Params& p, int item, char* smem) {
  char* ws = p.ws;
  const u16* Q = (const u16*)(ws + WS_Q);
  const u16* KS = (const u16*)(ws + WS_KS);
  const u16* KW = (const u16*)(ws + WS_KW);
  const u16* VTS = (const u16*)(ws + WS_VTS);
  const u16* VTW = (const u16*)(ws + WS_VTW);
  const u16* KCMP = (const u16*)(ws + WS_KCMP);
  const u16* VCMPT = (const u16*)(ws + WS_VCMPT);
  const float* NG = (const float*)(ws + WS_NG);
  u16* ONSA = (u16*)p.out;

  u16* KsB = (u16*)smem;
  int pb = 0;
#define Ks (KsB + pb * (2 * 64 * 72))
#define Vts (KsB + pb * (2 * 64 * 72) + 64 * 72)
  unsigned* imp_s = (unsigned*)(KsB + 4 * 64 * 72);
  unsigned char* sel8 = (unsigned char*)(imp_s + 32 * 65);

  const int tid = my_tid(), lane = tid & 63, wave = tid >> 6;
  const int lr = lane & 31, hh = lane >> 5;
  const int bg = item & 7, q32 = 127 - (item >> 3);
  const int b = bg >> 1, g = bg & 1;
  const int t0 = q32 * 32;
  const int head = g * 4 + wave;
  const int t = t0 + lr;
  const size_t row = (size_t)b * 4096 + t;
  const int qb = t0 >> 6;

  bf16x8 qf[4];
#pragma unroll
  for (int ks = 0; ks < 4; ++ks) qf[ks] = *(const bf16x8*)(Q + row * 512 + head * 64 + ks * 16 + hh * 8);
  float* ot_s = (float*)(sel8 + 256) + wave * 32 * 64 + lane;
  const float slope2 = fexp2(-(float)(head + 1)) * LOG2E;
  const float gc = NG[row * 32 + head], gs = NG[row * 32 + 8 + head], gw = NG[row * 32 + 16 + head];

  f32x16 O[2];

  hsync();
  for (int i = tid; i < 32 * 65; i += 256) imp_s[i] = 0u;

  const int nct = t0 / 1024 + 1;
  float m = -1e30f, l = 0.f;
  KVRegs kvr;
  kv_issue(kvr, KCMP + ((size_t)(bg * 256)) * 64, 64, VCMPT + (size_t)bg * 64 * 256, 256, tid);
#pragma unroll 1
  for (int c = 0; c < nct; ++c) {
    kv_commit(kvr, Ks, Vts, tid);
    const int cn = (c + 1 < nct) ? c + 1 : 0;
    kv_issue(kvr, KCMP + ((size_t)(bg * 256 + 64 * cn)) * 64, 64, VCMPT + (size_t)bg * 64 * 256 + 64 * cn, 256, tid);
    attend_tile<16, false, 1, 1>(Ks, Vts, qf, O, m, l, t - (31 + 1024 * c), slope2, true, 0.f, nullptr, 0, lr, hh);
    pb ^= 1;
  }
  {
    float lt = l + __shfl_xor(l, 32);
    float invl = lt > 0.f ? 1.f / lt : 0.f;
#pragma unroll
    for (int e = 0; e < 16; ++e) { O[0][e] = 0.f; O[1][e] = 0.f; }
#pragma unroll 1
    for (int c = 0; c < nct; ++c) {
      kv_commit(kvr, Ks, Vts, tid);
      if (c + 1 < nct) kv_issue(kvr, KCMP + ((size_t)(bg * 256 + 64 * (c + 1))) * 64, 64, VCMPT + (size_t)bg * 64 * 256 + 64 * (c + 1), 256, tid);
      attend_tile<16, false, 1, 2>(Ks, Vts, qf, O, m, l, t - (31 + 1024 * c), slope2, true, invl, imp_s + lr * 65,
                                        c * 16, lr, hh);
      pb ^= 1;
    }
#pragma unroll
    for (int e = 0; e < 16; ++e) { ot_s[e * 64] = O[0][e] * gc; ot_s[(16 + e) * 64] = O[1][e] * gc; }
  }
  hsync();
  {
    const int tl = tid >> 3, part = tid & 7;
    unsigned bits = 0;
    if (qb <= 15) {
#pragma unroll
      for (int jj = 0; jj < 8; ++jj) if (part * 8 + jj <= qb) bits |= 1u << jj;
    } else {
      unsigned mine[8];
      int cnt[8];
#pragma unroll
      for (int jj = 0; jj < 8; ++jj) { mine[jj] = imp_s[tl * 65 + part * 8 + jj]; cnt[jj] = 0; }
      for (int jp = 1; jp <= qb - 2; ++jp) {
        unsigned v = imp_s[tl * 65 + jp];
#pragma unroll
        for (int jj = 0; jj < 8; ++jj) {
          int j = part * 8 + jj;
          cnt[jj] += ((v > mine[jj]) || (v == mine[jj] && jp < j)) ? 1 : 0;
        }
      }
#pragma unroll
      for (int jj = 0; jj < 8; ++jj) {
        int j = part * 8 + jj;
        bool f = (j == 0) || (j == qb) || (j == qb - 1);
        bool c = (j >= 1) && (j <= qb - 2) && (cnt[jj] < 13);
        if (f || c) bits |= 1u << jj;
      }
    }
    sel8[tl * 8 + part] = (unsigned char)bits;
  }
  hsync();
  {
    const unsigned* sel32 = (const unsigned*)sel8;
    const unsigned mylo = sel32[lr * 2], myhi = sel32[lr * 2 + 1];
    unsigned alo = mylo, ahi = myhi;
#pragma unroll
    for (int o = 16; o > 0; o >>= 1) { alo |= __shfl_xor(alo, o); ahi |= __shfl_xor(ahi, o); }
    alo = __builtin_amdgcn_readfirstlane(alo);
    ahi = __builtin_amdgcn_readfirstlane(ahi);
    m = -1e30f; l = 0.f;
#pragma unroll
    for (int e = 0; e < 16; ++e) { O[0][e] = 0.f; O[1][e] = 0.f; }
    u64 am = ((u64)ahi << 32) | (u64)alo;
    int j = -1;
    if (am) { j = __builtin_ctzll(am); am &= am - 1; }
    if (j >= 0) kv_issue(kvr, KS + ((size_t)(b * 4096 + 64 * j)) * 128 + g * 64, 128, VTS + (size_t)bg * 64 * 4096 + 64 * j, 4096, tid);
#pragma unroll 1
    while (j >= 0) {
      kv_commit(kvr, Ks, Vts, tid);
      int jn = -1;
      if (am) { jn = __builtin_ctzll(am); am &= am - 1; }
      if (jn >= 0) kv_issue(kvr, KS + ((size_t)(b * 4096 + 64 * jn)) * 128 + g * 64, 128, VTS + (size_t)bg * 64 * 4096 + 64 * jn, 4096, tid);
      bool ls = (j < 32) ? ((mylo >> j) & 1u) : ((myhi >> (j - 32)) & 1u);
      if (j < qb) attend_tile<1, false, 2, 0>(Ks, Vts, qf, O, m, l, t - 64 * j, slope2, ls, 0.f, nullptr, 0, lr, hh);
      else attend_tile<1, false, 1, 0>(Ks, Vts, qf, O, m, l, t - 64 * j, slope2, ls, 0.f, nullptr, 0, lr, hh);
      pb ^= 1;
      j = jn;
    }
    float lt = l + __shfl_xor(l, 32);
    float sc = lt > 0.f ? gs / lt : 0.f;
#pragma unroll
    for (int e = 0; e < 16; ++e) { ot_s[e * 64] += O[0][e] * sc; ot_s[(16 + e) * 64] += O[1][e] * sc; }
  }
  {
    m = -1e30f; l = 0.f;
#pragma unroll
    for (int e = 0; e < 16; ++e) { O[0][e] = 0.f; O[1][e] = 0.f; }
    const int kbase = (t0 & ~63) - 512;
    int i0 = 0;
    if (kbase < 0) i0 = (-kbase) >> 6;
    kv_issue(kvr, KW + ((size_t)(b * 4096 + kbase + 64 * i0)) * 128 + g * 64, 128, VTW + (size_t)bg * 64 * 4096 + kbase + 64 * i0, 4096, tid);
#pragma unroll 1
    for (int i = i0; i < 9; ++i) {
      const int k0 = kbase + 64 * i;
      kv_commit(kvr, Ks, Vts, tid);
      if (i + 1 < 9) kv_issue(kvr, KW + ((size_t)(b * 4096 + k0 + 64)) * 128 + g * 64, 128, VTW + (size_t)bg * 64 * 4096 + k0 + 64, 4096, tid);
      if (i >= 1 && i <= 7) attend_tile<1, false, 0, 0>(Ks, Vts, qf, O, m, l, t - k0, slope2, true, 0.f, nullptr, 0, lr, hh);
      else attend_tile<1, true, 1, 0>(Ks, Vts, qf, O, m, l, t - k0, slope2, true, 0.f, nullptr, 0, lr, hh);
      pb ^= 1;
    }
    float lt = l + __shfl_xor(l, 32);
    float sc = lt > 0.f ? gw / lt : 0.f;
#pragma unroll
    for (int e = 0; e < 16; ++e) { O[0][e] = ot_s[e * 64] + O[0][e] * sc; O[1][e] = ot_s[(16 + e) * 64] + O[1][e] * sc; }
  }
#pragma unroll
  for (int dt = 0; dt < 2; ++dt)
#pragma unroll
    for (int q4 = 0; q4 < 4; ++q4) {
      int d0 = dt * 32 + q4 * 8 + hh * 4;
      uint2 o;
      o.x = pack2(O[dt][q4 * 4 + 0], O[dt][q4 * 4 + 1]);
      o.y = pack2(O[dt][q4 * 4 + 2], O[dt][q4 * 4 + 3]);
      *(uint2*)(ONSA + row * 512 + head * 64 + d0) = o;
    }
  hsync();
}

#undef Ks
#undef Vts

DI void conv_item(const Params& p, int item, char* smem) {
  char* ws = p.ws;
  const u16* GLU = (const u16*)(ws + WS_GLU);
  u16* CACT = (u16*)p.out + (size_t)T_TOK * 512;
  float* cs = (float*)smem;
  const int tid = my_tid(), lane = tid & 63, wave = tid >> 6;
  const int b = item >> 8, t0 = (item & 255) * 16;
  const int c0 = tid * 2;
  const float2 bias = *(const float2*)(p.b_dw + c0);
  unsigned rowv[46];
#pragma unroll
  for (int r = 0; r < 46; ++r) {
    int tt = t0 - 30 + r;
    rowv[r] = 0u;
    if (tt >= 0) rowv[r] = *(const unsigned*)(GLU + ((size_t)(b * 4096 + tt)) * 512 + c0);
  }
  hsync();
#pragma unroll
  for (int pass = 0; pass < 2; ++pass) {
    float w[31];
#pragma unroll
    for (int k = 0; k < 31; ++k) w[k] = p.w_dw[k * 512 + c0 + pass];
#pragma unroll
    for (int tl = 0; tl < 16; ++tl) {
      float a0 = pass ? bias.y : bias.x;
#pragma unroll
      for (int k = 0; k < 31; ++k) a0 += w[k] * (pass ? bfhi(rowv[tl + k]) : bflo(rowv[tl + k]));
      cs[tl * 520 + c0 + pass] = a0;
    }
  }
  hsync();
#pragma unroll
  for (int q = 0; q < 4; ++q) {
    const int tl = wave * 4 + q;
    float v[8];
    float sum = 0.f;
#pragma unroll
    for (int i = 0; i < 8; ++i) { v[i] = cs[tl * 520 + lane + 64 * i]; sum += v[i]; }
    float mean = wave_sum(sum) * (1.f / 512.f);
    float sq = 0.f;
#pragma unroll
    for (int i = 0; i < 8; ++i) { float d = v[i] - mean; sq += d * d; }
    float rstd = rsqrtf(wave_sum(sq) * (1.f / 512.f) + 1e-6f);
#pragma unroll
    for (int i = 0; i < 8; ++i) {
      int c = lane + 64 * i;
      float y = (v[i] - mean) * rstd * p.g_ln[c] + p.b_ln[c];
      float sl = y * sigmoidf_(y);
      CACT[((size_t)(b * 4096 + t0 + tl)) * 512 + c] = f2bf(sl);
    }
  }
  hsync();
}

DI void phase_mix(const Params& p, char* smem) {
  {
    int rnd = 0;
    for (int it = vb_id(); it < 1024; it += vb_n(), ++rnd) {
      const int item = (rnd & 1) ? (1023 - (it - rnd * vb_n())) - ((rnd - 1) * vb_n()) : it;
      if (item >= 0 && item < 1024) attn_item(p, item, smem);
    }
  }
  for (int it = vb_id(); it < 1024; it += vb_n()) conv_item(p, it, smem);
}

DI void phase_merge(const Params& p, char* smem) {
  char* ws = p.ws;
  const u16* ONSA = (const u16*)p.out;
  const u16* CACT = (const u16*)p.out + (size_t)T_TOK * 512;
  const u16* WA = (const u16*)(ws + WS_WT_NSA);
  const u16* WB = (const u16*)(ws + WS_WT_CONV);
  const u16* MG = (const u16*)(ws + WS_MG);
  u16* MERGED = (u16*)(ws + WS_XN);
  const int tid = tid512(), lane = tid & 63, wave = tid >> 6;
  const int wm = wave >> 2, wn = wave & 3, lr = lane & 31, hh = lane >> 5;
  for (int kk = 0;; ++kk) {
    int mt, nt;
    if (!xcd_tile(kk, 8, 8, mt, nt)) break;
    const int m0 = mt * 256, n0 = nt * 128;
    f32x16 ya[2][2], yb[2][2];
    zero_acc<2>(ya);
    zero_acc<2>(yb);
    gemm512<2>(ya, [&](int r) { return WA + (size_t)(n0 + r) * 512; }, 64, [&](int r) { return ONSA + (size_t)(m0 + r) * 512; }, 64, 8, smem);
    gemm512<2>(yb, [&](int r) { return WB + (size_t)(n0 + r) * 512; }, 64, [&](int r) { return CACT + (size_t)(m0 + r) * 512; }, 64, 8, smem);
#pragma unroll
    for (int i = 0; i < 2; ++i)
#pragma unroll
      for (int j = 0; j < 2; ++j)
#pragma unroll
        for (int q4 = 0; q4 < 4; ++q4) {
          const int f = n0 + wm * 64 + i * 32 + q4 * 8 + hh * 4;
          const size_t t = m0 + wn * 64 + j * 32 + lr;
          const uint2 ga = *(const uint2*)(MG + t * 2048 + f);
          const uint2 gb = *(const uint2*)(MG + t * 2048 + 1024 + f);
          uint2 o;
          o.x = pack2(bflo(ga.x) * ya[i][j][q4 * 4 + 0] + bflo(gb.x) * yb[i][j][q4 * 4 + 0],
                      bfhi(ga.x) * ya[i][j][q4 * 4 + 1] + bfhi(gb.x) * yb[i][j][q4 * 4 + 1]);
          o.y = pack2(bflo(ga.y) * ya[i][j][q4 * 4 + 2] + bflo(gb.y) * yb[i][j][q4 * 4 + 2],
                      bfhi(ga.y) * ya[i][j][q4 * 4 + 3] + bfhi(gb.y) * yb[i][j][q4 * 4 + 3]);
          *(uint2*)(MERGED + t * 1024 + f) = o;
        }
  }
}

DI void phase_wo(const Params& p, char* smem) {
  char* ws = p.ws;
  const u16* MERGED = (const u16*)(ws + WS_XN);
  const u16* WT = (const u16*)(ws + WS_WT_O);
  float* X1 = p.out;
  const int tid = tid512(), lane = tid & 63, wave = tid >> 6;
  const int wm = wave >> 2, wn = wave & 3, lr = lane & 31, hh = lane >> 5;
  for (int kk = 0;; ++kk) {
    int mt, nt;
    if (!xcd_tile(kk, 4, 8, mt, nt)) break;
    const int m0 = mt * 256, n0 = nt * 256;
    f32x16 acc[4][2];
    zero_acc<4>(acc);
    gemm512<4>(acc, [&](int r) { return WT + (size_t)(n0 + r) * 1024; }, 64, [&](int r) { return MERGED + (size_t)(m0 + r) * 1024; }, 64, 16, smem);
#pragma unroll
    for (int i = 0; i < 4; ++i)
#pragma unroll
      for (int j = 0; j < 2; ++j)
#pragma unroll
        for (int q4 = 0; q4 < 4; ++q4) {
          const int f = n0 + wm * 128 + i * 32 + q4 * 8 + hh * 4;
          const size_t t = m0 + wn * 64 + j * 32 + lr;
          float4 xv = *(const float4*)(p.x + t * 1024 + f);
          xv.x += acc[i][j][q4 * 4 + 0]; xv.y += acc[i][j][q4 * 4 + 1];
          xv.z += acc[i][j][q4 * 4 + 2]; xv.w += acc[i][j][q4 * 4 + 3];
          *(float4*)(X1 + t * 1024 + f) = xv;
        }
  }
}

DI void phase_norm2(const Params& p) {
  const int tid = my_tid(); const int lane = tid & 63, wave = tid >> 6;
  u16* XN2 = (u16*)(p.ws + WS_Q);
  for (int it = vb_id(); it < 1024; it += vb_n()) {
    int row = it * 16 + wave * 4;
    rms_rows<4>(p.out + (size_t)row * 1024, p.g_ffn, XN2 + (size_t)row * 1024, lane);
  }
}

DI void phase_pq(const Params& p, char* smem) {
  char* ws = p.ws;
  const u16* XN2 = (const u16*)(ws + WS_Q);
  const u16* WT = (const u16*)(ws + WS_WT_PQ);
  u16* PQ = (u16*)(ws + WS_MG);
  const int tid = tid512(), lane = tid & 63, wave = tid >> 6;
  const int wm = wave >> 2, wn = wave & 3, lr = lane & 31, hh = lane >> 5;
  for (int kk = 0;; ++kk) {
    int mt, nt;
    if (!xcd_tile(kk, 8, 8, mt, nt)) break;
    const int m0 = mt * 256, n0 = nt * 256;
    f32x16 acc[4][2];
    zero_acc<4>(acc);
    gemm512<4>(acc, [&](int r) { return WT + (size_t)(n0 + r) * 1024; }, 64, [&](int r) { return XN2 + (size_t)(m0 + r) * 1024; }, 64, 16, smem);
#pragma unroll
    for (int i = 0; i < 4; ++i)
#pragma unroll
      for (int j = 0; j < 2; ++j)
#pragma unroll
        for (int q4 = 0; q4 < 4; ++q4) {
          const int f = n0 + wm * 128 + i * 32 + q4 * 8 + hh * 4;
          const size_t t = m0 + wn * 64 + j * 32 + lr;
          uint2 o;
          o.x = pack2(acc[i][j][q4 * 4 + 0], acc[i][j][q4 * 4 + 1]);
          o.y = pack2(acc[i][j][q4 * 4 + 2], acc[i][j][q4 * 4 + 3]);
          *(uint2*)(PQ + t * 2048 + f) = o;
        }
  }
}

template <int LOGN>
DI void bitonic_sort_desc(unsigned (&a)[1 << LOGN]) {
  constexpr int N = 1 << LOGN;
#pragma unroll
  for (int ks = 1; ks <= LOGN; ++ks)
#pragma unroll
    for (int js = ks - 1; js >= 0; --js)
#pragma unroll
      for (int i = 0; i < N; ++i) {
        const int k = 1 << ks, j = 1 << js, l = i ^ j;
        if (l > i) {
          const bool desc = ((i & k) == 0) || (ks == LOGN);
          const unsigned x = a[i], y = a[l];
          const unsigned hi = max(x, y), lo = min(x, y);
          a[i] = desc ? hi : lo;
          a[l] = desc ? lo : hi;
        }
      }
}
DI void merge_top16(unsigned (&a)[16], const unsigned (&b)[16]) {
#pragma unroll
  for (int i = 0; i < 16; ++i) a[i] = max(a[i], b[15 - i]);
#pragma unroll
  for (int js = 3; js >= 0; --js)
#pragma unroll
    for (int i = 0; i < 16; ++i) {
      const int j = 1 << js, l = i ^ j;
      if (l > i) {
        const unsigned x = a[i], y = a[l];
        a[i] = max(x, y);
        a[l] = min(x, y);
      }
    }
}

DI void peer_top16(const u16* __restrict__ PQrow, const u16* __restrict__ SK, unsigned (&top)[16], int lr, int hh) {
  bf16x8 qf[8];
#pragma unroll
  for (int ks = 0; ks < 8; ++ks) qf[ks] = *(const bf16x8*)(PQrow + ks * 16 + hh * 8);
  unsigned g[4][16];
#pragma unroll
  for (int kt = 0; kt < 4; ++kt) {
    f32x16 acc;
#pragma unroll
    for (int e = 0; e < 16; ++e) acc[e] = 0.f;
#pragma unroll
    for (int ks = 0; ks < 8; ++ks) {
      bf16x8 a = *(const bf16x8*)(SK + (size_t)(kt * 32 + lr) * 128 + ks * 16 + hh * 8);
      acc = MFMA32(a, qf[ks], acc);
    }
#pragma unroll
    for (int e = 0; e < 16; ++e) {
      int kidx = kt * 32 + crow(e, hh);
      g[kt][e] = (f2ord(acc[e]) & ~127u) | (unsigned)(127 - kidx);
    }
    bitonic_sort_desc<4>(g[kt]);
  }
  merge_top16(g[0], g[1]);
  merge_top16(g[2], g[3]);
  merge_top16(g[0], g[2]);
  unsigned other[16];
#pragma unroll
  for (int i = 0; i < 16; ++i) other[i] = (unsigned)__shfl_xor((int)g[0][i], 32);
  merge_top16(g[0], other);
#pragma unroll
  for (int i = 0; i < 16; ++i) top[i] = g[0][i];
}

template <bool STORE>
DI void peer_item(const Params& p, int item, char* smem) {
  char* ws = p.ws;
  const u16* PQ = (const u16*)(ws + WS_MG);
  const u16* SUBK = (const u16*)(ws + WS_SUBK);
  const u16* XN2 = (const u16*)(ws + WS_Q);
  int* e_s = (int*)smem;
  float* g_s = (float*)(e_s + 32 * 128);
  const int tid = my_tid(), lane = tid & 63, wave = tid >> 6;
  const int lr = lane & 31, hh = lane >> 5;
  const int tok0 = item * 32;
  hsync();
  {
    unsigned top1[16], top2[16];
    {
      unsigned tA1[16], tA2[16], tB1[16], tB2[16];
      const u16* pqA = PQ + (size_t)(tok0 + lr) * 2048 + (wave * 2) * 256;
      peer_top16(pqA, SUBK + (size_t)(wave * 4 + 0) * 128 * 128, tA1, lr, hh);
      peer_top16(pqA + 128, SUBK + (size_t)(wave * 4 + 1) * 128 * 128, tA2, lr, hh);
      peer_top16(pqA + 256, SUBK + (size_t)(wave * 4 + 2) * 128 * 128, tB1, lr, hh);
      peer_top16(pqA + 384, SUBK + (size_t)(wave * 4 + 3) * 128 * 128, tB2, lr, hh);
#pragma unroll
      for (int i = 0; i < 16; ++i) { top1[i] = hh ? tB1[i] : tA1[i]; top2[i] = hh ? tB2[i] : tA2[i]; }
    }
    const int hd = wave * 2 + hh;
    unsigned ckey[16][16];
#pragma unroll
    for (int a = 0; a < 16; ++a)
#pragma unroll
      for (int bq = 0; bq < 16; ++bq)
        if ((a + 1) * (bq + 1) <= 16)
          ckey[a][bq] = (f2ord(ord2f(top1[a] & ~127u) + ord2f(top2[bq] & ~127u)) & ~255u) | (unsigned)(255 - (a * 16 + bq));
    unsigned wkey[16];
    int we[16];
#pragma unroll
    for (int r = 0; r < 16; ++r) {
      unsigned mx = 0u;
#pragma unroll
      for (int a = 0; a < 16; ++a)
#pragma unroll
        for (int bq = 0; bq < 16; ++bq)
          if ((a + 1) * (bq + 1) <= 16) mx = max(mx, ckey[a][bq]);
#pragma unroll
      for (int a = 0; a < 16; ++a)
#pragma unroll
        for (int bq = 0; bq < 16; ++bq)
          if ((a + 1) * (bq + 1) <= 16) ckey[a][bq] = (ckey[a][bq] == mx) ? 0u : ckey[a][bq];
      wkey[r] = mx;
      const int cidx = 255 - (int)(mx & 255u);
      const int wa = cidx >> 4, wb = cidx & 15;
      unsigned t1 = top1[0], t2 = top2[0];
#pragma unroll
      for (int a = 1; a < 16; ++a) { t1 = (wa == a) ? top1[a] : t1; t2 = (wb == a) ? top2[a] : t2; }
      we[r] = (127 - (int)(t1 & 127u)) * 128 + (127 - (int)(t2 & 127u));
    }
    float cs0 = ord2f(wkey[0] & ~255u);
    float ex[16], sum = 0.f;
#pragma unroll
    for (int r = 0; r < 16; ++r) { ex[r] = __expf(ord2f(wkey[r] & ~255u) - cs0); sum += ex[r]; }
    float inv = 1.f / sum;
#pragma unroll
    for (int r = 0; r < 16; ++r) {
      e_s[lr * 128 + hd * 16 + r] = we[r];
      g_s[lr * 128 + hd * 16 + r] = ex[r] * inv;
    }
  }
  hsync();
  const unsigned char* U8 = (const unsigned char*)(ws + WS_UBF);
  const float* SU = (const float*)(ws + WS_SU);
  const float* SV = (const float*)(ws + WS_SV);
  int* EG = (int*)(ws + WS_XN);
  float* AG = (float*)(ws + WS_XN + (size_t)T_TOK * 128 * 4);
  const bool b5 = (lane & 32) != 0, b4 = (lane & 16) != 0, b3 = (lane & 8) != 0;
#pragma unroll 1
  for (int ti = 0; ti < 8; ++ti) {
    const int tl = wave * 8 + ti;
    const size_t tok = (size_t)tok0 + tl;
    float xf[16];
    {
#pragma unroll
      for (int i = 0; i < 4; ++i) {
        const uint2 xv = *(const uint2*)(XN2 + tok * 1024 + 256 * i + lane * 4);
        xf[4 * i] = bflo(xv.x); xf[4 * i + 1] = bfhi(xv.x); xf[4 * i + 2] = bflo(xv.y); xf[4 * i + 3] = bfhi(xv.y);
      }
    }
#pragma unroll 2
    for (int k = 0; k < 128; k += 8) {
      u32x4 uq[8];
      const int emine = e_s[tl * 128 + k + (lane >> 3)];
      const float gmine = g_s[tl * 128 + k + (lane >> 3)];
      const float su = SU[emine], sv = SV[emine];
#pragma unroll
      for (int u = 0; u < 8; ++u) {
        int e = e_s[tl * 128 + k + u];
        uq[u] = *(const u32x4*)(U8 + (size_t)e * 1024 + lane * 16);
      }
      float part[8];
#pragma unroll
      for (int u = 0; u < 8; ++u) {
        float d = 0.f;
#pragma unroll
        for (int i = 0; i < 4; ++i) {
          f32x2_t lo = __builtin_amdgcn_cvt_pk_f32_fp8((int)uq[u][i], false);
          f32x2_t hi = __builtin_amdgcn_cvt_pk_f32_fp8((int)uq[u][i], true);
          d += xf[4 * i] * lo.x + xf[4 * i + 1] * lo.y + xf[4 * i + 2] * hi.x + xf[4 * i + 3] * hi.y;
        }
        part[u] = d;
      }
      float q4[4], r2[2], h;
#pragma unroll
      for (int j = 0; j < 4; ++j) {
        float mine = b5 ? part[j + 4] : part[j];
        float other = b5 ? part[j] : part[j + 4];
        q4[j] = mine + __shfl_xor(other, 32);
      }
#pragma unroll
      for (int j = 0; j < 2; ++j) {
        float mine = b4 ? q4[j + 2] : q4[j];
        float other = b4 ? q4[j] : q4[j + 2];
        r2[j] = mine + __shfl_xor(other, 16);
      }
      {
        float mine = b3 ? r2[1] : r2[0];
        float other = b3 ? r2[0] : r2[1];
        h = mine + __shfl_xor(other, 8);
      }
      h += __shfl_xor(h, 4);
      h += __shfl_xor(h, 2);
      h += __shfl_xor(h, 1);
      const float amine = gelu_exact(h * su) * gmine * sv;
      if ((lane & 7) == 0) {
        EG[tok * 128 + k + (lane >> 3)] = emine;
        AG[tok * 128 + k + (lane >> 3)] = amine;
      }
    }
  }
  hsync();
}

DI void peer_item_v(const Params& p, int item) {
  char* ws = p.ws;
  const unsigned char* V8 = (const unsigned char*)(ws + WS_VBF);
  const int* EG = (const int*)(ws + WS_XN);
  const float* AG = (const float*)(ws + WS_XN + (size_t)T_TOK * 128 * 4);
  const int tid = my_tid(), lane = tid & 63, wave = tid >> 6;
#pragma unroll 1
  for (int ti = 0; ti < 8; ++ti) {
    const size_t tok = (size_t)item * 32 + wave * 8 + ti;
    const int e_lo = EG[tok * 128 + lane], e_hi = EG[tok * 128 + 64 + lane];
    const int a_lo = __float_as_int(AG[tok * 128 + lane]), a_hi = __float_as_int(AG[tok * 128 + 64 + lane]);
    float out[16];
#pragma unroll
    for (int i = 0; i < 16; ++i) out[i] = 0.f;
    u32x4 vqa[8], vqb[8];
#define V_ISSUE(VQ, G)                                                                              \
    {                                                                                                \
      const int g_ = (G);                                                                            \
      _Pragma("unroll") for (int u = 0; u < 8; ++u) {                                                \
        const int e = (g_ < 8) ? __builtin_amdgcn_readlane(e_lo, (g_ & 7) * 8 + u)                   \
                               : __builtin_amdgcn_readlane(e_hi, (g_ & 7) * 8 + u);                  \
        (VQ)[u] = *(const u32x4*)(V8 + (size_t)e * 1024 + lane * 16);                                \
      }                                                                                              \
      __builtin_amdgcn_sched_barrier(0);                                                             \
    }
#define V_CONSUME(VQ, G)                                                                            \
    {                                                                                                \
      const int g_ = (G);                                                                            \
      _Pragma("unroll") for (int u = 0; u < 8; ++u) {                                                \
        const float a = __int_as_float((g_ < 8) ? __builtin_amdgcn_readlane(a_lo, (g_ & 7) * 8 + u)  \
                                                : __builtin_amdgcn_readlane(a_hi, (g_ & 7) * 8 + u)); \
        _Pragma("unroll") for (int i = 0; i < 4; ++i) {                                              \
          f32x2_t lo = __builtin_amdgcn_cvt_pk_f32_fp8((int)(VQ)[u][i], false);                      \
          f32x2_t hi = __builtin_amdgcn_cvt_pk_f32_fp8((int)(VQ)[u][i], true);                       \
          out[4 * i] += a * lo.x; out[4 * i + 1] += a * lo.y; out[4 * i + 2] += a * hi.x; out[4 * i + 3] += a * hi.y; \
        }                                                                                            \
      }                                                                                              \
    }
    V_ISSUE(vqa, 0)
#pragma unroll 1
    for (int g = 0; g < 16; g += 2) {
      V_ISSUE(vqb, g + 1)
      V_CONSUME(vqa, g)
      if (g + 2 < 16) V_ISSUE(vqa, g + 2)
      V_CONSUME(vqb, g + 1)
    }
#undef V_ISSUE
#undef V_CONSUME
    float* orow = p.out + tok * 1024 + lane * 4;
    float4 y[4];
    float ss = 0.f;
#pragma unroll
    for (int i = 0; i < 4; ++i) {
      y[i] = *(const float4*)(orow + 256 * i);
      y[i].x += out[4 * i]; y[i].y += out[4 * i + 1]; y[i].z += out[4 * i + 2]; y[i].w += out[4 * i + 3];
      ss += y[i].x * y[i].x + y[i].y * y[i].y + y[i].z * y[i].z + y[i].w * y[i].w;
    }
    ss = wave_sum(ss);
    const float r = rsqrtf(ss * (1.f / 1024.f) + 1e-6f);
#pragma unroll
    for (int i = 0; i < 4; ++i) {
      float4 g = *(const float4*)(p.g_final + 256 * i + lane * 4);
      y[i].x *= r * g.x; y[i].y *= r * g.y; y[i].z *= r * g.z; y[i].w *= r * g.w;
      *(float4*)(orow + 256 * i) = y[i];
    }
  }
}

template <bool STORE>
DI void phase_peer(const Params& p, char* smem) {
  for (int it = vb_id(); it < 512; it += vb_n()) peer_item<STORE>(p, it, smem);
}
DI void phase_peer_v(const Params& p) {
  for (int it = vb_id(); it < 512; it += vb_n()) peer_item_v(p, it);
}

__global__ void __launch_bounds__(512) fwd_megakernel(Params p) {
  extern __shared__ __attribute__((aligned(16))) char smem[];
  cg::grid_group grid = cg::this_grid();
  __shared__ uint4 xb_words;
  if (threadIdx.x == 0) {
    xb_words = make_uint4(0u, 0u, 0u, 0u);
    hsync_impl(true);
  }
  __syncthreads();
  if (p.ws == nullptr) grid.sync();
  XcdBarrier xb = xcd_barrier_post((unsigned*)(p.ws + WS_BAR), (volatile LAS unsigned*)&xb_words);
  char* hsm = smem + half_id() * HALF_LDS;
  phase_prep(p, hsm, 0, vb_id());
  xcd_barrier(xb);
  phase_inproj(p, smem);
  xcd_barrier(xb);
  phase_compress(p, hsm);
  phase_prep(p, hsm, 1, (vb_id() + vb_n() - 128) % vb_n());
  xcd_barrier(xb);
  phase_mix(p, hsm);
  xcd_barrier(xb);
  phase_merge(p, smem);
  xcd_barrier(xb);
  phase_wo(p, smem);
  xcd_barrier(xb);
  phase_norm2(p);
  xcd_barrier(xb);
  phase_pq(p, smem);
  xcd_barrier(xb);
  phase_peer<true>(p, hsm);
  xcd_barrier(xb);
  phase_peer_v(p);
}

extern "C" void kernel_launch(void* const* d_in, const int* in_sizes, int n_in, void* d_out, int out_size, void* d_ws,
                              size_t ws_size, hipStream_t stream) {
  static int grid_blocks = 0;
  if (!grid_blocks) {
    int dev = 0, cus = 0, per_cu = 0;
    hipGetDevice(&dev);
    hipDeviceGetAttribute(&cus, hipDeviceAttributeMultiprocessorCount, dev);
    hipFuncSetAttribute((const void*)fwd_megakernel, hipFuncAttributeMaxDynamicSharedMemorySize, DYN_LDS);
    hipOccupancyMaxActiveBlocksPerMultiprocessor(&per_cu, fwd_megakernel, 512, DYN_LDS);
    if (per_cu > 1) per_cu = 1;
    if (per_cu < 1) per_cu = 1;
    grid_blocks = cus * per_cu;
  }
  Params p{};
  const float** pf = (const float**)&p;
  for (int i = 0; i < 22; ++i) pf[i] = (const float*)d_in[i];
  p.out = (float*)d_out;
  p.ws = (char*)d_ws;
  hipMemsetAsync((char*)d_ws + WS_BAR, 0, 3456 * 4, stream);
  void* args[] = {&p};
  hipError_t e = hipLaunchCooperativeKernel((void*)fwd_megakernel, dim3(grid_blocks), dim3(512), args, DYN_LDS, stream);
  if (e != hipSuccess) fprintf(stderr, "cooperative launch failed: %s (grid %d)\n", hipGetErrorString(e), grid_blocks);
}
```
